# Optimizing an MI355X kernel written in HIP

```python
import math
import jax
import jax.numpy as jnp
from jax import lax
import numpy as np


D_MODEL = 2048
BATCH = 8
SEQ = 2048
DEPTH = 4

N_EVEN = (DEPTH + 1) // 2
N_ODD = DEPTH // 2
RMS_EPS = 1e-6

DA_HEADS = 8
DA_QK_DIM = 64
DA_V_DIM = 2 * DA_QK_DIM
DA_WIDTH = DA_HEADS * DA_V_DIM
DA_QK_WIDTH = DA_HEADS * 2 * DA_QK_DIM
DA_QBLOCK = 128

GD_HEADS = 8
GD_DK = 128
GD_DV = 128
GD_WIDTH = GD_HEADS * GD_DV
GD_QKV = 2 * GD_HEADS * GD_DK + GD_WIDTH
GD_CONV = 4
GD_CHUNK = 64

EVEN_MIX = DA_WIDTH + GD_WIDTH
EV_A_END = 2 * DA_QK_WIDTH + 2 * DA_WIDTH
EV_SPLITS = (DA_QK_WIDTH, 2 * DA_QK_WIDTH, 2 * DA_QK_WIDTH + DA_WIDTH, EV_A_END, EV_A_END + GD_QKV, EV_A_END + GD_QKV + GD_WIDTH, EV_A_END + GD_QKV + GD_WIDTH + GD_HEADS)
EVEN_IN = EV_A_END + GD_QKV + GD_WIDTH + 2 * GD_HEADS

SW_HEADS = 32
SW_KV_HEADS = 4
SW_GROUP = SW_HEADS // SW_KV_HEADS
SW_HEAD_DIM = 64
SW_WIDTH = SW_HEADS * SW_HEAD_DIM
SW_KV_WIDTH = SW_KV_HEADS * SW_HEAD_DIM
SW_WINDOW = 128
ODD_SPLITS = (SW_WIDTH, SW_WIDTH + SW_KV_WIDTH, SW_WIDTH + 2 * SW_KV_WIDTH)
ODD_IN = 2 * SW_WIDTH + 2 * SW_KV_WIDTH

kernel_name = 'hybrid_diffattn_gdn_swa_adaln'


def rms_norm(x, w):
    xf = x.astype(jnp.float32)
    y = xf * lax.rsqrt(jnp.mean(xf * xf, axis=-1, keepdims=True) + RMS_EPS)
    return (y * w.astype(jnp.float32)).astype(x.dtype)


def l2_normalize(x):
    xf = x.astype(jnp.float32)
    return (xf * lax.rsqrt(jnp.sum(xf * xf, axis=-1, keepdims=True) + RMS_EPS)).astype(x.dtype)


def alibi_slopes(n):
    return 2.0 ** (-8.0 * jnp.arange(1, n + 1, dtype=jnp.float32) / n)


def causal_depthwise_conv(x, w):
    k_size, ch = w.shape
    return lax.conv_general_dilated(x, w[:, None, :].astype(x.dtype), window_strides=(1,), padding=[(k_size - 1, 0)], dimension_numbers=('NWC', 'WIO', 'NWC'), feature_group_count=ch)


def differential_attention(q, k, v, lam, lam_init, subln_w):
    b, t, h = q.shape[:3]
    scale = DA_QK_DIM ** -0.5
    slopes = alibi_slopes(h)[:, None, None, None]
    outs = []
    for blk in range(t // DA_QBLOCK):
        q0 = blk * DA_QBLOCK
        q1 = q0 + DA_QBLOCK
        dist = (jnp.arange(q0, q1)[:, None] - jnp.arange(q1)[None, :]).astype(jnp.float32)
        s = jnp.einsum('bqhmd,bkhmd->bhmqk', q[:, q0:q1], k[:, :q1]).astype(jnp.float32) * scale
        s = jnp.where(dist >= 0, s - slopes * dist, -jnp.inf)
        p = jax.nn.softmax(s, axis=-1)
        a = p[:, :, 0] - lam * p[:, :, 1]
        outs.append(jnp.einsum('bhqk,bkhd->bqhd', a.astype(v.dtype), v[:, :q1]))
    o = jnp.concatenate(outs, axis=1)
    o = rms_norm(o, subln_w) * (1.0 - lam_init)
    return o.reshape(b, t, h * DA_V_DIM)


def gated_delta_rule(q, k, v, g, beta):
    b, t, h, dk = q.shape
    dv = v.shape[-1]
    cs = GD_CHUNK
    n = t // cs
    f32 = jnp.float32

    def chunks(xs):
        xs = xs.astype(f32).reshape(b, n, cs, h, *xs.shape[3:])
        return jnp.moveaxis(xs, (1, 3), (0, 2))

    qc, kc, vc = chunks(q), chunks(k), chunks(v)
    gc = jnp.cumsum(chunks(g), axis=-1)
    bc = chunks(beta)
    idx = jnp.arange(cs)
    tril = idx[:, None] >= idx[None, :]
    strict = idx[:, None] > idx[None, :]
    decay = jnp.exp(jnp.where(tril, gc[..., :, None] - gc[..., None, :], -jnp.inf))
    kk = jnp.einsum('nbhid,nbhjd->nbhij', kc, kc)
    m_low = jnp.where(strict, bc[..., :, None] * kk * decay, 0.0)
    rhs = jnp.concatenate([bc[..., None] * vc, bc[..., None] * kc * jnp.exp(gc)[..., None]], axis=-1)
    sol = lax.linalg.triangular_solve(m_low + jnp.eye(cs, dtype=f32), rhs, left_side=True, lower=True, unit_diagonal=True)
    u, w = sol[..., :dv], sol[..., dv:]
    qk = jnp.where(tril, jnp.einsum('nbhid,nbhjd->nbhij', qc, kc) * decay, 0.0)

    def step(state, inp):
        q_i, k_i, u_i, w_i, g_i, qk_i = inp
        v_new = u_i - jnp.einsum('bhcd,bhde->bhce', w_i, state)
        o_i = jnp.einsum('bhcd,bhde->bhce', q_i * jnp.exp(g_i)[..., None], state) + jnp.einsum('bhij,bhje->bhie', qk_i, v_new)
        g_last = g_i[..., -1]
        state = state * jnp.exp(g_last)[..., None, None] + jnp.einsum('bhcd,bhce->bhde', k_i * jnp.exp(g_last[..., None] - g_i)[..., None], v_new)
        return state, o_i

    s0 = jnp.zeros((b, h, dk, dv), f32)
    _, o = lax.scan(step, s0, (qc, kc, u, w, gc, qk))
    return jnp.moveaxis(o, (0, 2), (1, 3)).reshape(b, t, h, dv)


def sliding_window_attention(q, k, v, sinks):
    b, t, hkv, grp, d = q.shape
    w = SW_WINDOW
    nb = t // w
    scale = d ** -0.5

    def band(xs):
        xb = xs.reshape(b, nb, w, hkv, d)
        prev = jnp.pad(xb, ((0, 0), (1, 0), (0, 0), (0, 0), (0, 0)))[:, :-1]
        return jnp.concatenate([prev, xb], axis=2)

    kb, vb = band(k), band(v)
    s = jnp.einsum('bnqhgd,bnkhd->bnhgqk', q.reshape(b, nb, w, hkv, grp, d), kb).astype(jnp.float32) * scale
    dist = jnp.arange(w)[:, None] + w - jnp.arange(2 * w)[None, :]
    key_abs = jnp.arange(nb)[:, None, None] * w + jnp.arange(2 * w)[None, None, :] - w
    valid = (dist >= 0) & (dist < w) & (key_abs >= 0)
    slopes = alibi_slopes(hkv * grp).reshape(hkv, grp)[:, :, None, None]
    s = jnp.where(valid[None, :, None, None], s - slopes * dist.astype(jnp.float32), -jnp.inf)
    sink = sinks.astype(jnp.float32).reshape(hkv, grp)[:, :, None, None]
    m = jnp.maximum(jnp.max(s, axis=-1, keepdims=True), sink)
    p = jnp.exp(s - m)
    p = p / (jnp.sum(p, axis=-1, keepdims=True) + jnp.exp(sink - m))
    o = jnp.einsum('bnhgqk,bnkhd->bnqhgd', p.astype(v.dtype), vb)
    return o.reshape(b, t, hkv * grp * d)


def even_mixer(h, w_in, w_out, lam_q1, lam_k1, lam_q2, lam_k2, diff_norm, conv_w, a_log, dt_bias, delta_norm, lam_init):
    b, t, _ = h.shape
    f32 = jnp.float32
    proj = h @ w_in
    a_q, a_k, a_v, a_z, b_qkv, b_z, b_beta, b_a = jnp.split(proj, EV_SPLITS, axis=-1)
    lam = jnp.exp(jnp.sum(lam_q1.astype(f32) * lam_k1.astype(f32))) - jnp.exp(jnp.sum(lam_q2.astype(f32) * lam_k2.astype(f32))) + lam_init
    o_a = differential_attention(a_q.reshape(b, t, DA_HEADS, 2, DA_QK_DIM), a_k.reshape(b, t, DA_HEADS, 2, DA_QK_DIM), a_v.reshape(b, t, DA_HEADS, DA_V_DIM), lam, lam_init, diff_norm)
    qkv = jax.nn.silu(causal_depthwise_conv(b_qkv, conv_w))
    g_q, g_k, g_v = jnp.split(qkv, (GD_HEADS * GD_DK, 2 * GD_HEADS * GD_DK), axis=-1)
    g_q = l2_normalize(g_q.reshape(b, t, GD_HEADS, GD_DK)) * (GD_DK ** -0.5)
    g_k = l2_normalize(g_k.reshape(b, t, GD_HEADS, GD_DK))
    g_v = g_v.reshape(b, t, GD_HEADS, GD_DV)
    beta = jax.nn.sigmoid(b_beta.astype(f32))
    g = -jnp.exp(a_log.astype(f32)) * jax.nn.softplus(b_a.astype(f32) + dt_bias.astype(f32))
    o_b = gated_delta_rule(g_q, g_k, g_v, g, beta).astype(h.dtype)
    o_b = rms_norm(o_b, delta_norm).reshape(b, t, GD_WIDTH)
    y = jnp.concatenate([o_a * jax.nn.silu(a_z), o_b * jax.nn.silu(b_z)], axis=-1)
    return y @ w_out


def odd_mixer(h, w_in, w_out, sinks):
    b, t, _ = h.shape
    proj = h @ w_in
    q, k, v, z = jnp.split(proj, ODD_SPLITS, axis=-1)
    o = sliding_window_attention(q.reshape(b, t, SW_KV_HEADS, SW_GROUP, SW_HEAD_DIM), k.reshape(b, t, SW_KV_HEADS, SW_HEAD_DIM), v.reshape(b, t, SW_KV_HEADS, SW_HEAD_DIM), sinks)
    return (o * jax.nn.silu(z)) @ w_out


def setup_inputs(seed: int = 0) -> dict:
    key = jax.random.key(seed)
    ks = jax.random.split(key, 21)
    f32 = jnp.float32
    d = D_MODEL

    def nrm(k, shape, s):
        return jax.random.normal(k, shape, f32) * s

    dt = jnp.exp(jax.random.uniform(ks[14], (N_EVEN, GD_HEADS), f32, math.log(1e-3), math.log(1e-1)))
    return {
        'x': nrm(ks[0], (BATCH, SEQ, d), 1.0),
        'c': nrm(ks[1], (BATCH, d), 1.0),
        'norm_w': 1.0 + nrm(ks[2], (DEPTH, d), 0.02),
        'ada_w': nrm(ks[3], (DEPTH, d, 3 * d), 0.5 * d ** -0.5),
        'ada_b': nrm(ks[4], (DEPTH, 3 * d), 0.02),
        'ev_w_in': nrm(ks[5], (N_EVEN, d, EVEN_IN), d ** -0.5),
        'ev_w_out': nrm(ks[6], (N_EVEN, EVEN_MIX, d), EVEN_MIX ** -0.5),
        'ev_lam_q1': nrm(ks[7], (N_EVEN, DA_QK_DIM), 0.1),
        'ev_lam_k1': nrm(ks[8], (N_EVEN, DA_QK_DIM), 0.1),
        'ev_lam_q2': nrm(ks[9], (N_EVEN, DA_QK_DIM), 0.1),
        'ev_lam_k2': nrm(ks[10], (N_EVEN, DA_QK_DIM), 0.1),
        'ev_diff_norm': 1.0 + nrm(ks[11], (N_EVEN, DA_V_DIM), 0.02),
        'ev_conv_w': nrm(ks[12], (N_EVEN, GD_CONV, GD_QKV), GD_CONV ** -0.5),
        'ev_A_log': jnp.log(jax.random.uniform(ks[13], (N_EVEN, GD_HEADS), f32, 1.0, 16.0)),
        'ev_dt_bias': dt + jnp.log(-jnp.expm1(-dt)),
        'ev_delta_norm': 1.0 + nrm(ks[15], (N_EVEN, GD_DV), 0.02),
        'od_w_in': nrm(ks[16], (N_ODD, d, ODD_IN), d ** -0.5),
        'od_w_out': nrm(ks[17], (N_ODD, SW_WIDTH, d), SW_WIDTH ** -0.5),
        'od_sinks': nrm(ks[18], (N_ODD, SW_HEADS), 0.5),
        'final_norm_w': 1.0 + nrm(ks[19], (d,), 0.02),
    }


def reference(x, c, norm_w, ada_w, ada_b, ev_w_in, ev_w_out, ev_lam_q1, ev_lam_k1, ev_lam_q2, ev_lam_k2, ev_diff_norm, ev_conv_w, ev_A_log, ev_dt_bias, ev_delta_norm, od_w_in, od_w_out, od_sinks, final_norm_w):
    cond = jax.nn.silu(c)
    for layer in range(DEPTH):
        mod = cond @ ada_w[layer] + ada_b[layer]
        shift, scale, gate = jnp.split(mod[:, None, :], 3, axis=-1)
        h = rms_norm(x, norm_w[layer]) * (1.0 + scale) + shift
        i = layer // 2
        if layer % 2 == 0:
            lam_init = 0.8 - 0.6 * math.exp(-0.3 * layer)
            y = even_mixer(h, ev_w_in[i], ev_w_out[i], ev_lam_q1[i], ev_lam_k1[i], ev_lam_q2[i], ev_lam_k2[i], ev_diff_norm[i], ev_conv_w[i], ev_A_log[i], ev_dt_bias[i], ev_delta_norm[i], lam_init)
        else:
            y = odd_mixer(h, od_w_in[i], od_w_out[i], od_sinks[i])
        x = x + gate * y
    return rms_norm(x, final_norm_w)
```

```cpp
#define PROBE_SYNCS 0
#define PROBE_DUP 0
#include <hip/hip_runtime.h>
#include <hip/hip_cooperative_groups.h>
#include <cstdio>
#include <cstdint>
namespace cg = cooperative_groups;

#define LAS __attribute__((address_space(3)))
typedef unsigned short bf16_t;
typedef short bf16x8 __attribute__((ext_vector_type(8)));
typedef short v4i16_t __attribute__((ext_vector_type(4)));
typedef float f32x4 __attribute__((ext_vector_type(4)));
typedef float f32x2 __attribute__((ext_vector_type(2)));
typedef unsigned u32x4 __attribute__((ext_vector_type(4)));
typedef unsigned u32x2 __attribute__((ext_vector_type(2)));
typedef __bf16 bf16x2_t __attribute__((ext_vector_type(2)));

constexpr int DM = 2048, NB = 8, SEQ = 2048, MROWS = NB * SEQ;
constexpr int EVEN_IN = 8208, EV_MAIN = 8192, ODD_IN = 4608;
constexpr int NTHREADS = 512, NWAVES = 8;
constexpr int LDS_BYTES = 147456;
constexpr int QSLOT_OFF = LDS_BYTES - 64;
constexpr int XBST_OFF = LDS_BYTES - 32;
constexpr float LOG2E = 1.4426950408889634f;

constexpr size_t WS_CTL = 0;
constexpr size_t WS_BAR = 4096;
constexpr size_t CTL_BYTES = 32768;
constexpr size_t WS_MOD = CTL_BYTES;
constexpr size_t WS_WT_EVIN = WS_MOD + (size_t)4 * 8 * 6144 * 4;
constexpr size_t WS_WT_EVTAIL = WS_WT_EVIN + (size_t)2 * EV_MAIN * DM * 2;
constexpr size_t WS_WT_EVOUT = WS_WT_EVTAIL + (size_t)2 * 16 * DM * 2;
constexpr size_t WS_WT_ODIN = WS_WT_EVOUT + (size_t)2 * DM * DM * 2;
constexpr size_t WS_WT_ODOUT = WS_WT_ODIN + (size_t)2 * ODD_IN * DM * 2;
constexpr size_t WS_HY = WS_WT_ODOUT + (size_t)2 * DM * DM * 2;
constexpr size_t WS_PROJ = WS_HY + (size_t)MROWS * DM * 2;
constexpr size_t WS_TAIL = WS_PROJ + (size_t)MROWS * EV_MAIN * 2;
constexpr size_t WS_GW = WS_TAIL + (size_t)MROWS * 16 * 4;
constexpr size_t WS_GQG = WS_GW + (size_t)2048 * 64 * 128 * 2;
constexpr size_t WS_GKD = WS_GQG + (size_t)2048 * 64 * 128 * 2;
constexpr size_t WS_GQK = WS_GKD + (size_t)2048 * 64 * 128 * 2;
constexpr size_t WS_GUT = WS_GQK + (size_t)2048 * 64 * 64 * 2;
constexpr size_t WS_GGE = WS_GUT + (size_t)2048 * 64 * 128 * 2;
constexpr size_t WS_XS = WS_GGE + (size_t)2048 * 4;
constexpr size_t WS_SSQP = WS_XS + (size_t)MROWS * DM * 2;
constexpr size_t WS_RSTD = WS_SSQP + (size_t)MROWS * 32 * 4;
constexpr size_t WS_CS = WS_RSTD + (size_t)MROWS * 4;
constexpr int SHW_LD = 8208;
constexpr size_t WS_SHW = WS_CS + (size_t)3 * 8 * DM * 4;
constexpr size_t WS_END = WS_SHW + (size_t)3 * 8 * SHW_LD * 4;

__device__ __forceinline__ unsigned pkbf(float lo, float hi) { f32x2 v = {lo, hi}; bf16x2_t b = __builtin_convertvector(v, bf16x2_t); return __builtin_bit_cast(unsigned, b); }
__device__ __forceinline__ float bflo(unsigned u) { return __uint_as_float(u << 16); }
__device__ __forceinline__ float bfhi(unsigned u) { return __uint_as_float(u & 0xffff0000u); }
__device__ __forceinline__ float bf2f(bf16_t u) { return __uint_as_float(((unsigned)u) << 16); }
__device__ __forceinline__ float siluf(float v) { return v * __builtin_amdgcn_rcpf(1.f + __builtin_amdgcn_exp2f(-1.4426950408889634f * v)); }
__device__ __forceinline__ float rsqf(float v) { return __builtin_amdgcn_rsqf(v); }
__device__ __forceinline__ float ex2(float v) { return __builtin_amdgcn_exp2f(v); }
__device__ __forceinline__ float wave_sum(float v) {
#pragma unroll
    for (int o = 1; o < 64; o <<= 1) v += __shfl_xor(v, o);
    return v;
}
__device__ __forceinline__ float row16_sum(float v) {
    v += __builtin_bit_cast(float, __builtin_amdgcn_update_dpp(0, __builtin_bit_cast(int, v), 0x128, 0xf, 0xf, false));
    v += __builtin_bit_cast(float, __builtin_amdgcn_update_dpp(0, __builtin_bit_cast(int, v), 0x124, 0xf, 0xf, false));
    v += __builtin_bit_cast(float, __builtin_amdgcn_update_dpp(0, __builtin_bit_cast(int, v), 0x122, 0xf, 0xf, false));
    v += __builtin_bit_cast(float, __builtin_amdgcn_update_dpp(0, __builtin_bit_cast(int, v), 0x121, 0xf, 0xf, false));
    return v;
}
#define SCHED_FENCE() __builtin_amdgcn_sched_barrier(0)
__device__ __forceinline__ bf16x8 cat8(v4i16_t a, v4i16_t b) { return __builtin_shufflevector(a, b, 0, 1, 2, 3, 4, 5, 6, 7); }
__device__ __forceinline__ v4i16_t ldtr(const LAS unsigned char* p) { return __builtin_amdgcn_ds_read_tr16_b64_v4i16((LAS v4i16_t*)p); }
__device__ __forceinline__ v4i16_t ld8(const LAS unsigned char* p) { return *(const LAS v4i16_t*)p; }
__device__ __forceinline__ bf16x8 ld16(const LAS unsigned char* p) { return *(const LAS bf16x8*)p; }
__device__ __forceinline__ bf16x8 pack8(f32x4 a, f32x4 b) {
    u32x4 w; w.x = pkbf(a[0], a[1]); w.y = pkbf(a[2], a[3]); w.z = pkbf(b[0], b[1]); w.w = pkbf(b[2], b[3]);
    return __builtin_bit_cast(bf16x8, w);
}
#define MFMA16(a, b, c) __builtin_amdgcn_mfma_f32_16x16x32_bf16((a), (b), (c), 0, 0, 0)
#define LDS_WAIT() asm volatile("s_waitcnt lgkmcnt(0)" ::: "memory")
__device__ __forceinline__ int fresh_tid() { int t = threadIdx.x; asm volatile("" : "+v"(t)); return t; }
__device__ __forceinline__ int fresh_s(int v) { asm volatile("" : "+s"(v)); return v; }
template <class T> __device__ __forceinline__ T* fresh_p(T* p) { asm volatile("" : "+s"(p)); return p; }


#define XB_TMO      128
#define XB_XCNT(j)  (256  + 64 * (j))
#define XB_XSUB(j)  (1280 + 64 * (j))
#define XB_XGEN(j)  (2304 + 64 * (j))
#define XB_TOP      3328
#define XB_TOPGEN   3392
#define XCD_BAR_WORDS 3456
#define XB_SPIN_CAP (1u << 22)
__device__ __forceinline__ unsigned xb_ld(unsigned* p)              { return __hip_atomic_load(p, __ATOMIC_RELAXED, __HIP_MEMORY_SCOPE_AGENT); }
__device__ __forceinline__ unsigned xb_add(unsigned* p, unsigned v) { return __hip_atomic_fetch_add(p, v, __ATOMIC_RELAXED, __HIP_MEMORY_SCOPE_AGENT); }
__device__ __forceinline__ unsigned xb_xcc_id() { return (unsigned)__builtin_amdgcn_s_getreg((3 << 11) | 20) & 0xFu; }
#define XB_SPIN(cond, bar) do { unsigned _sp = 0; while (cond) { __builtin_amdgcn_s_sleep(1); \
    if ((++_sp & 255u) == 0u) { if (xb_ld(&(bar)[XB_TMO])) break; if (_sp > XB_SPIN_CAP) { atomicAdd(&(bar)[XB_TMO], 1u); break; } } } } while (0)
struct XcdBarrier { unsigned* bar; unsigned x; volatile LAS unsigned* st; };
__device__ __forceinline__ XcdBarrier xcd_barrier_post(unsigned* bar, volatile LAS unsigned* st) {
    XcdBarrier b; b.bar = bar; b.x = xb_xcc_id(); b.st = st;
    if (threadIdx.x == 0) (void)xb_add(&bar[XB_XCNT(b.x)], 1u);
    return b;
}
__device__ __forceinline__ void xcd_barrier_complete(unsigned* bar, unsigned x, unsigned& nloc, unsigned& nx) {
    const unsigned G = gridDim.x * gridDim.y * gridDim.z;
    unsigned sum, cnt, mine, sp = 0u;
    for (;;) {
        sum = 0u; cnt = 0u; mine = 0u;
#pragma unroll
        for (unsigned j = 0; j < 16; ++j) { const unsigned c = xb_ld(&bar[XB_XCNT(j)]); sum += c; cnt += (c > 0u) ? 1u : 0u; mine = (j == x) ? c : mine; }
        if (sum == G) break;
        __builtin_amdgcn_s_sleep(1);
        if ((++sp & 255u) == 0u) { if (xb_ld(&bar[XB_TMO])) break; if (sp > XB_SPIN_CAP) { atomicAdd(&bar[XB_TMO], 1u); break; } }
    }
    nloc = mine > 0u ? mine : 1u; nx = cnt > 0u ? cnt : 1u;
}
__device__ __forceinline__ void xcd_barrier(const XcdBarrier& b) {
    asm volatile("s_waitcnt vmcnt(0)" ::: "memory");
    __syncthreads();
    if (threadIdx.x == 0) {
        unsigned* bar = b.bar;
        __builtin_amdgcn_s_waitcnt(0);
        unsigned nloc = b.st[0], nx = b.st[1];
        if (nloc == 0u) { xcd_barrier_complete(bar, b.x, nloc, nx); b.st[0] = nloc; b.st[1] = nx; }
        const unsigned old = xb_add(&bar[XB_XSUB(b.x)], 1u);
        const unsigned gen = old / nloc;
        if (old + 1u == (gen + 1u) * nloc) {
            __builtin_amdgcn_fence(__ATOMIC_RELEASE, "agent");
            asm volatile("s_waitcnt vmcnt(0)" ::: "memory");
            const unsigned og = xb_add(&bar[XB_TOP], 1u);
            const unsigned tg = og / nx;
            if (og + 1u == (tg + 1u) * nx) xb_add(&bar[XB_TOPGEN], 1u);
            else XB_SPIN(xb_ld(&bar[XB_TOPGEN]) == tg, bar);
            __builtin_amdgcn_fence(__ATOMIC_ACQUIRE, "agent");
            xb_add(&bar[XB_XGEN(b.x)], 1u);
            asm volatile("s_waitcnt vmcnt(0)" ::: "memory");
        } else {
            XB_SPIN(xb_ld(&bar[XB_XGEN(b.x)]) == gen, bar);
            __builtin_amdgcn_fence(__ATOMIC_ACQUIRE, "agent");
            asm volatile("s_waitcnt vmcnt(0)" ::: "memory");
        }
    }
    __syncthreads();
}

namespace pg8 {
constexpr int BM = 256, BK = 64, HALF = 128, HTB = HALF * BK * 2, STAGE_BYTES = 8 * HTB, NXCD = 8, WGM = 2;
__host__ __device__ __forceinline__ int lds_byte(int r, int c) { const int st = (r >> 4) * 2 + (c >> 5), rr = r & 15, cc = c & 31, ob = rr * 64 + cc * 2; return st * 1024 + (ob ^ (((ob >> 9) & 1) << 5)); }
__host__ __device__ __forceinline__ void stage_rc(int b, int& R, int& C) { const int st = b / 1024, sb = b % 1024, swz = sb ^ (((sb >> 9) & 1) << 5); R = (st >> 1) * 16 + swz / 64; C = (st & 1) * 32 + (swz % 64) / 2; }
__host__ __device__ __forceinline__ int perm32(int rho) { const int n = rho >> 4, i = rho & 15; return 8 * (i >> 2) + 4 * n + (i & 3); }
struct Unit { int pm, pn; };
struct Gemm { const bf16_t* A; const bf16_t* Bt; int M, N, K; };
struct StaticOrder {
    int nM, nN, nwg, G, c;
    __host__ __device__ void init(int M, int N, int G_, int c_) { nM = M / BM; nN = N / BM; nwg = nM * nN; G = G_; c = c_; }
    __host__ __device__ bool next(int i, Unit& u) const {
        const long L = (long)i * G + c; if (L >= nwg) return false;
        int wgid = (int)L; { const int q = nwg / NXCD, r = nwg % NXCD, xcd = wgid % NXCD, off = wgid / NXCD; wgid = (xcd < r ? xcd * (q + 1) : r * (q + 1) + (xcd - r) * q) + off; }
        const int nig = WGM * nN, gid = wgid / nig, fm = gid * WGM, gsz = (nM - fm) < WGM ? (nM - fm) : WGM;
        u.pm = fm + ((wgid % nig) % gsz); u.pn = (wgid % nig) / gsz; return true;
    }
    __device__ __forceinline__ void a_ready(const Unit&) const {}
    __device__ __forceinline__ void done(const Unit&) const {}
};
struct EpiProj {
    static constexpr bool PERM = true, AFTER_DRAIN = false;
    bf16_t* O; int ldc;
    __device__ __forceinline__ void operator()(const f32x4 (&acc)[2][2][4][2], const Unit& u, int wr, int wc, int fr, int fq) const {
        const int row0 = u.pm * BM + wr * 64 + fr, col0 = u.pn * BM + wc * 32 + 8 * fq;
#pragma unroll
        for (int ai = 0; ai < 2; ++ai)
#pragma unroll
            for (int m = 0; m < 4; ++m) { bf16_t* rowp = O + (size_t)(row0 + ai * HALF + m * 16) * ldc + col0;
#pragma unroll
                for (int bj = 0; bj < 2; ++bj) { const f32x4 v0 = acc[ai][bj][m][0], v1 = acc[ai][bj][m][1];
                    u32x4 w; w.x = pkbf(v0[0], v0[1]); w.y = pkbf(v0[2], v0[3]); w.z = pkbf(v1[0], v1[1]); w.w = pkbf(v1[2], v1[3]);
                    *(u32x4*)(rowp + bj * HALF) = w; } }
    }
};
struct EpiResid {
    static constexpr bool PERM = true, AFTER_DRAIN = false;
    const float* xin; float* xout; const float* gate;
    __device__ __forceinline__ void operator()(const f32x4 (&acc)[2][2][4][2], const Unit& u, int wr, int wc, int fr, int fq) const {
        const int row0 = u.pm * BM + wr * 64 + fr, col0 = u.pn * BM + wc * 32 + 8 * fq;
        const int b = (u.pm * BM) >> 11;
        f32x4 gv[2][2];
#pragma unroll
        for (int bj = 0; bj < 2; ++bj)
#pragma unroll
            for (int n = 0; n < 2; ++n) gv[bj][n] = *(const f32x4*)(gate + (size_t)b * 6144 + col0 + bj * HALF + 4 * n);
        typedef const __attribute__((address_space(1))) f32x4 GF4; typedef __attribute__((address_space(1))) f32x4 GF4W;
        const __attribute__((address_space(1))) float* gxin = (const __attribute__((address_space(1))) float*)xin; __attribute__((address_space(1))) float* gxout = (__attribute__((address_space(1))) float*)xout;
        f32x4 xc[2][2], xn[2][2];
#pragma unroll
        for (int bj = 0; bj < 2; ++bj)
#pragma unroll
            for (int n = 0; n < 2; ++n) xc[bj][n] = *(const GF4*)(gxin + (size_t)row0 * DM + col0 + bj * HALF + 4 * n);
#pragma unroll
        for (int grp = 0; grp < 8; ++grp) {
            const int ai = grp >> 2, m = grp & 3;
            const size_t ro = (size_t)(row0 + ai * HALF + m * 16) * DM + col0;
            if (grp + 1 < 8) {
                const size_t rn = (size_t)(row0 + ((grp + 1) >> 2) * HALF + ((grp + 1) & 3) * 16) * DM + col0;
#pragma unroll
                for (int bj = 0; bj < 2; ++bj)
#pragma unroll
                    for (int n = 0; n < 2; ++n) xn[bj][n] = *(const GF4*)(gxin + rn + bj * HALF + 4 * n);
            }
#pragma unroll
            for (int bj = 0; bj < 2; ++bj)
#pragma unroll
                for (int n = 0; n < 2; ++n) *(GF4W*)(gxout + ro + bj * HALF + 4 * n) = xc[bj][n] + gv[bj][n] * acc[ai][bj][m][n];
#pragma unroll
            for (int bj = 0; bj < 2; ++bj)
#pragma unroll
                for (int n = 0; n < 2; ++n) xc[bj][n] = xn[bj][n];
        }
    }
};

struct EpiProjN {
    static constexpr bool PERM = true, AFTER_DRAIN = false;
    bf16_t* O; int ldc; const float* rstd; const float* shw;
    __device__ __forceinline__ void operator()(const f32x4 (&acc)[2][2][4][2], const Unit& u, int wr, int wc, int fr, int fq) const {
        const int row0 = u.pm * BM + wr * 64 + fr, col0 = u.pn * BM + wc * 32 + 8 * fq;
        const int b = (u.pm * BM) >> 11;
        f32x4 sv[2][2];
#pragma unroll
        for (int bj = 0; bj < 2; ++bj)
#pragma unroll
            for (int n = 0; n < 2; ++n) sv[bj][n] = *(const f32x4*)(shw + (size_t)b * SHW_LD + col0 + bj * HALF + 4 * n);
#pragma unroll
        for (int ai = 0; ai < 2; ++ai)
#pragma unroll
            for (int m = 0; m < 4; ++m) { const int row = row0 + ai * HALF + m * 16; const float rs = rstd[row]; bf16_t* rowp = O + (size_t)row * ldc + col0;
#pragma unroll
                for (int bj = 0; bj < 2; ++bj) { const f32x4 v0 = acc[ai][bj][m][0] * rs + sv[bj][0], v1 = acc[ai][bj][m][1] * rs + sv[bj][1];
                    u32x4 w; w.x = pkbf(v0[0], v0[1]); w.y = pkbf(v0[2], v0[3]); w.z = pkbf(v1[0], v1[1]); w.w = pkbf(v1[2], v1[3]);
                    *(u32x4*)(rowp + bj * HALF) = w; } }
    }
};
struct EpiResid2 {
    static constexpr bool PERM = true, AFTER_DRAIN = false;
    const float* xin; float* xout; const float* gate; const float* cs; bf16_t* xs; float* ssqp;
    __device__ __forceinline__ void operator()(const f32x4 (&acc)[2][2][4][2], const Unit& u, int wr, int wc, int fr, int fq) const {
        const int row0 = u.pm * BM + wr * 64 + fr, col0 = u.pn * BM + wc * 32 + 8 * fq;
        const int b = (u.pm * BM) >> 11;
        f32x4 gv[2][2], cv[2][2];
#pragma unroll
        for (int bj = 0; bj < 2; ++bj)
#pragma unroll
            for (int n = 0; n < 2; ++n) { gv[bj][n] = *(const f32x4*)(gate + (size_t)b * 6144 + col0 + bj * HALF + 4 * n); cv[bj][n] = *(const f32x4*)(cs + (size_t)b * DM + col0 + bj * HALF + 4 * n); }
        typedef const __attribute__((address_space(1))) f32x4 GF4; typedef __attribute__((address_space(1))) f32x4 GF4W;
        const __attribute__((address_space(1))) float* gxin = (const __attribute__((address_space(1))) float*)xin; __attribute__((address_space(1))) float* gxout = (__attribute__((address_space(1))) float*)xout;
        f32x4 xc[2][2], xn[2][2];
#pragma unroll
        for (int bj = 0; bj < 2; ++bj)
#pragma unroll
            for (int n = 0; n < 2; ++n) xc[bj][n] = *(const GF4*)(gxin + (size_t)row0 * DM + col0 + bj * HALF + 4 * n);
#pragma unroll
        for (int grp = 0; grp < 8; ++grp) {
            const int ai = grp >> 2, m = grp & 3, row = row0 + ai * HALF + m * 16;
            const size_t ro = (size_t)row * DM + col0;
            if (grp + 1 < 8) {
                const size_t rn = (size_t)(row0 + ((grp + 1) >> 2) * HALF + ((grp + 1) & 3) * 16) * DM + col0;
#pragma unroll
                for (int bj = 0; bj < 2; ++bj)
#pragma unroll
                    for (int n = 0; n < 2; ++n) xn[bj][n] = *(const GF4*)(gxin + rn + bj * HALF + 4 * n);
            }
            float ss = 0.f;
#pragma unroll
            for (int bj = 0; bj < 2; ++bj) {
                const f32x4 y0 = xc[bj][0] + gv[bj][0] * acc[ai][bj][m][0], y1 = xc[bj][1] + gv[bj][1] * acc[ai][bj][m][1];
                *(GF4W*)(gxout + ro + bj * HALF) = y0; *(GF4W*)(gxout + ro + bj * HALF + 4) = y1;
                ss += (y0[0] * y0[0] + y0[1] * y0[1]) + (y0[2] * y0[2] + y0[3] * y0[3]) + (y1[0] * y1[0] + y1[1] * y1[1]) + (y1[2] * y1[2] + y1[3] * y1[3]);
                const f32x4 z0 = y0 * cv[bj][0], z1 = y1 * cv[bj][1];
                u32x4 w; w.x = pkbf(z0[0], z0[1]); w.y = pkbf(z0[2], z0[3]); w.z = pkbf(z1[0], z1[1]); w.w = pkbf(z1[2], z1[3]);
                *(u32x4*)(xs + ro + bj * HALF) = w;
            }
            ss += __shfl_xor(ss, 16); ss += __shfl_xor(ss, 32);
            if (fq == 0) ssqp[(size_t)row * 32 + u.pn * 4 + wc] = ss;
#pragma unroll
            for (int bj = 0; bj < 2; ++bj)
#pragma unroll
                for (int n = 0; n < 2; ++n) xc[bj][n] = xn[bj][n];
        }
    }
};
#define PG8_LAS LAS
template <class Epi, class Sched, bool ALIGN_EPI = false, bool SP2 = false>
__device__ __forceinline__ void gemm_phase(PG8_LAS unsigned char* lds, const Gemm g, const Sched& S, const Epi& E) {
    const int tid = fresh_tid(), wid = __builtin_amdgcn_readfirstlane(tid >> 6), lane = tid & 63, wr = wid >> 2, wc = wid & 3, fr = lane & 15, fq = lane >> 4;
    const int K = g.K, nt = K / BK;
    unsigned voffA[2], voffB[2];
#pragma unroll
    for (int i = 0; i < 2; ++i) { int R, C; stage_rc(tid * 16 + i * 8192, R, C); const int Rb = Epi::PERM ? ((R & ~31) + perm32(R & 31)) : R;
        voffA[i] = (unsigned)(R * K + C) * 2u; voffB[i] = (unsigned)(Rb * K + C) * 2u; }
    const size_t kstep = (size_t)(BK * 2);
    const size_t hstep = (size_t)HALF * K * 2;
    const size_t tstep = 2 * hstep;
    const unsigned ldsw = (unsigned)wid * 1024u;
    const int aoff = lds_byte(wr * 64 + fr, fq * 8), boff = lds_byte(wc * 32 + fr, fq * 8);
#define PG8_SA(b, h) (((b) * 2 + (h)) * HTB)
#define PG8_SB(b, h) ((4 + (b) * 2 + (h)) * HTB)
#define PG8_STAGE(bufoff, gbase, voff) do { _Pragma("unroll") for (int _i = 0; _i < 2; ++_i) \
        __builtin_amdgcn_global_load_lds((const unsigned*)((const char*)(gbase) + (voff)[_i]), (PG8_LAS unsigned*)(lds + (bufoff) + ldsw + _i * 8192), 16, 0, 0); } while (0)
#define PG8_LDA(dst, b, h) do { _Pragma("unroll") for (int m = 0; m < 4; ++m) _Pragma("unroll") for (int k = 0; k < 2; ++k) dst[m][k] = *(const PG8_LAS bf16x8*)(lds + PG8_SA(b, h) + aoff + m * 2048 + k * 1024); } while (0)
#define PG8_LDB(dst, b, h) do { _Pragma("unroll") for (int n = 0; n < 2; ++n) _Pragma("unroll") for (int k = 0; k < 2; ++k) dst[n][k] = *(const PG8_LAS bf16x8*)(lds + PG8_SB(b, h) + boff + n * 2048 + k * 1024); } while (0)
#define PG8_MMA(ai, bj, At, Bt) do { __builtin_amdgcn_s_setprio(1); _Pragma("unroll") for (int m = 0; m < 4; ++m) _Pragma("unroll") for (int n = 0; n < 2; ++n) _Pragma("unroll") for (int k = 0; k < 2; ++k) \
        acc[ai][bj][m][n] = __builtin_amdgcn_mfma_f32_16x16x32_bf16(Bt[n][k], At[m][k], acc[ai][bj][m][n], 0, 0, 0); __builtin_amdgcn_s_setprio(0); } while (0)
#define PG8_WAIT_V(n) asm volatile("s_waitcnt vmcnt(" #n ")" ::: "memory")
#define PG8_WAIT_L(n) asm volatile("s_waitcnt lgkmcnt(" #n ")" ::: "memory")
#define PG8_BAR __builtin_amdgcn_s_barrier()
#define PG8_SCHED __builtin_amdgcn_sched_barrier(0)
    Unit cur, nxt; int ui = 0;
    if (!S.next(0, cur)) return;
    f32x4 acc[2][2][4][2];
#pragma unroll
    for (int a = 0; a < 2; ++a)
#pragma unroll
        for (int b = 0; b < 2; ++b)
#pragma unroll
            for (int m = 0; m < 4; ++m)
#pragma unroll
                for (int n = 0; n < 2; ++n) acc[a][b][m][n] = (f32x4){0.f, 0.f, 0.f, 0.f};
    bf16x8 At[4][2], B0[2][2], B1[2][2];
    const char* cA = (const char*)g.A + (size_t)cur.pm * tstep; const char* cB = (const char*)g.Bt + (size_t)cur.pn * tstep;
    S.a_ready(cur);
    if constexpr (SP2) {
        PG8_STAGE(PG8_SB(0, 0), cB, voffB); PG8_STAGE(PG8_SB(0, 1), cB + hstep, voffB); PG8_STAGE(PG8_SA(0, 0), cA, voffA); PG8_STAGE(PG8_SA(0, 1), cA + hstep, voffA);
        if (wr == 1) PG8_BAR;
        PG8_WAIT_V(2); PG8_BAR;
        PG8_STAGE(PG8_SB(1, 0), cB + kstep, voffB); PG8_STAGE(PG8_SA(1, 0), cA + kstep, voffA); PG8_STAGE(PG8_SB(1, 1), cB + hstep + kstep, voffB);
        PG8_WAIT_V(6); PG8_BAR;
    } else {
        PG8_STAGE(PG8_SB(0, 0), cB, voffB); PG8_STAGE(PG8_SA(0, 0), cA, voffA); PG8_STAGE(PG8_SB(0, 1), cB + hstep, voffB); PG8_STAGE(PG8_SA(0, 1), cA + hstep, voffA);
        if (wr == 1) PG8_BAR;
        PG8_WAIT_V(4); PG8_BAR;
        PG8_STAGE(PG8_SB(1, 0), cB + kstep, voffB); PG8_STAGE(PG8_SA(1, 0), cA + kstep, voffA); PG8_STAGE(PG8_SB(1, 1), cB + hstep + kstep, voffB);
        PG8_WAIT_V(6); PG8_BAR;
    }
    for (;;) {
        const bool has_next = S.next(ui + 1, nxt);
        const char* nA = has_next ? (const char*)g.A + (size_t)nxt.pm * tstep : cA; const char* nB = has_next ? (const char*)g.Bt + (size_t)nxt.pn * tstep : cB;
        for (int t = 0; t < nt; t += 2) {
            const bool last = (t == nt - 2);
            const char* a1 = cA + (size_t)(t + 1) * kstep;
            const char* a2 = last ? nA : cA + (size_t)(t + 2) * kstep; const char* b2 = last ? nB : cB + (size_t)(t + 2) * kstep;
            const char* a3 = a2 + kstep; const char* b3 = b2 + kstep;
            if (last && has_next) S.a_ready(nxt);
            if constexpr (SP2) {
            PG8_LDB(B0, 0, 0); PG8_LDB(B1, 0, 1); PG8_SCHED; PG8_LDA(At, 0, 0); PG8_STAGE(PG8_SA(1, 1), a1 + hstep, voffA);
            PG8_WAIT_V(8); PG8_WAIT_L(0); PG8_BAR; PG8_MMA(0, 0, At, B0); PG8_MMA(0, 1, At, B1); PG8_BAR; PG8_SCHED;
            PG8_LDA(At, 0, 1); PG8_STAGE(PG8_SB(0, 0), b2, voffB); PG8_STAGE(PG8_SB(0, 1), b2 + hstep, voffB); PG8_STAGE(PG8_SA(0, 0), a2, voffA);
            PG8_WAIT_V(8); PG8_WAIT_L(0); PG8_BAR; PG8_MMA(1, 0, At, B0); PG8_MMA(1, 1, At, B1); PG8_BAR; PG8_SCHED;
            PG8_LDB(B0, 1, 0); PG8_LDB(B1, 1, 1); PG8_SCHED; PG8_LDA(At, 1, 0); PG8_STAGE(PG8_SA(0, 1), a2 + hstep, voffA);
            PG8_WAIT_V(8); PG8_WAIT_L(0); PG8_BAR; PG8_MMA(0, 0, At, B0); PG8_MMA(0, 1, At, B1); PG8_BAR; PG8_SCHED;
            PG8_LDA(At, 1, 1); PG8_STAGE(PG8_SB(1, 0), b3, voffB); PG8_STAGE(PG8_SB(1, 1), b3 + hstep, voffB); PG8_STAGE(PG8_SA(1, 0), a3, voffA);
            PG8_WAIT_V(8); PG8_WAIT_L(0); PG8_BAR; PG8_MMA(1, 0, At, B0); PG8_MMA(1, 1, At, B1); PG8_BAR; PG8_SCHED;
            } else {
            PG8_LDB(B0, 0, 0); PG8_SCHED; PG8_LDA(At, 0, 0); PG8_STAGE(PG8_SA(1, 1), a1 + hstep, voffA);
            PG8_WAIT_L(8); PG8_BAR; PG8_WAIT_L(0); PG8_MMA(0, 0, At, B0); PG8_BAR; PG8_SCHED;
            PG8_LDB(B1, 0, 1); PG8_STAGE(PG8_SB(0, 0), b2, voffB);
            PG8_BAR; PG8_WAIT_L(0); PG8_MMA(0, 1, At, B1); PG8_BAR;
            PG8_LDA(At, 0, 1); PG8_STAGE(PG8_SA(0, 0), a2, voffA);
            PG8_BAR; PG8_WAIT_L(0); PG8_MMA(1, 0, At, B0); PG8_BAR; PG8_SCHED;
            PG8_STAGE(PG8_SB(0, 1), b2 + hstep, voffB);
            PG8_WAIT_V(6); PG8_BAR; PG8_MMA(1, 1, At, B1); PG8_BAR;
            PG8_LDB(B0, 1, 0); PG8_SCHED; PG8_LDA(At, 1, 0); PG8_STAGE(PG8_SA(0, 1), a2 + hstep, voffA);
            PG8_WAIT_L(8); PG8_BAR; PG8_WAIT_L(0); PG8_MMA(0, 0, At, B0); PG8_BAR; PG8_SCHED;
            PG8_LDB(B1, 1, 1); PG8_STAGE(PG8_SB(1, 0), b3, voffB);
            PG8_BAR; PG8_WAIT_L(0); PG8_MMA(0, 1, At, B1); PG8_BAR;
            PG8_LDA(At, 1, 1); PG8_STAGE(PG8_SA(1, 0), a3, voffA);
            PG8_BAR; PG8_WAIT_L(0); PG8_MMA(1, 0, At, B0); PG8_BAR; PG8_SCHED;
            PG8_STAGE(PG8_SB(1, 1), b3 + hstep, voffB);
            PG8_WAIT_V(6); PG8_BAR; PG8_MMA(1, 1, At, B1); PG8_BAR;
            }
        }
        if constexpr (ALIGN_EPI) { if (wr == 0) PG8_BAR; }
        if constexpr (!Epi::AFTER_DRAIN) { E(acc, cur, wr, wc, fr, fq); S.done(cur); }
        if (!has_next) break;
#pragma unroll
        for (int a = 0; a < 2; ++a)
#pragma unroll
            for (int b = 0; b < 2; ++b)
#pragma unroll
                for (int m = 0; m < 4; ++m)
#pragma unroll
                    for (int n = 0; n < 2; ++n) acc[a][b][m][n] = (f32x4){0.f, 0.f, 0.f, 0.f};
        cur = nxt; cA = nA; cB = nB; ++ui;
        if constexpr (ALIGN_EPI) { if (wr == 1) PG8_BAR; }
    }
    PG8_WAIT_V(0);
    if constexpr (!ALIGN_EPI) { if (wr == 0) PG8_BAR; }
    PG8_BAR;
    if constexpr (Epi::AFTER_DRAIN) { E.fused(acc, cur, wr, wc, fr, fq, lds, wid, lane); S.done(cur); }
#undef PG8_SA
#undef PG8_SB
#undef PG8_STAGE
#undef PG8_LDA
#undef PG8_LDB
#undef PG8_MMA
#undef PG8_WAIT_V
#undef PG8_WAIT_L
#undef PG8_BAR
#undef PG8_SCHED
}
}

struct Params {
    const float* in[20];
    float* out;
    unsigned char* ws;
};

__device__ __forceinline__ void phase_mod(const Params& P, LAS unsigned char* L, int wg, int nwg) {
    LAS float* cond = (LAS float*)L;
    LAS float* red = (LAS float*)(L + 65536);
    const int tid = fresh_tid();
    const float* c = P.in[1]; const float* ada_w = P.in[3]; const float* ada_b = P.in[4];
    float* mod = (float*)(P.ws + WS_MOD);
    for (int i = tid; i < 8 * 2048; i += NTHREADS) { const float v = c[i]; cond[i] = v / (1.f + expf(-v)); }
    __syncthreads();
    const int cl = tid & 7, kg = tid >> 3;
    for (int item = wg; item < 768; item += nwg) {
        const int l = item / 192, cgp = item % 192;
        const float* W = ada_w + (size_t)l * 2048 * 6144 + cgp * 32 + cl * 4;
        f32x4 acc[8];
#pragma unroll
        for (int b = 0; b < 8; ++b) acc[b] = (f32x4){0.f, 0.f, 0.f, 0.f};
#pragma unroll 8
        for (int kk = 0; kk < 32; ++kk) {
            const int k = kk * 64 + kg;
            const f32x4 w = *(const f32x4*)(W + (size_t)k * 6144);
#pragma unroll
            for (int b = 0; b < 8; ++b) acc[b] += w * cond[b * 2048 + k];
        }
#pragma unroll
        for (int b = 0; b < 8; ++b) *(LAS f32x4*)(red + kg * 256 + b * 32 + cl * 4) = acc[b];
        __syncthreads();
        if (tid < 256) {
            float s = 0.f;
#pragma unroll 8
            for (int k2 = 0; k2 < 64; ++k2) s += red[k2 * 256 + tid];
            const int b = tid >> 5, cc = tid & 31, n = cgp * 32 + cc;
            mod[(size_t)(l * 8 + b) * 6144 + n] = s + ada_b[l * 6144 + n];
        }
        __syncthreads();
    }
}

__device__ __forceinline__ void transpose_item(const float* W, int K, int ldw, int nblk, bf16_t* WT, LAS float* scr, int item, int lane) {
    const int kb = item / nblk, nb = item % nblk, k0 = 64 * kb, n0 = 64 * nb;
    const int lr = lane >> 4, lc = (lane & 15) * 4;
    f32x4 v[16];
#pragma unroll
    for (int i = 0; i < 16; ++i) v[i] = *(const f32x4*)(W + (size_t)(k0 + 4 * i + lr) * ldw + n0 + lc);
#pragma unroll
    for (int i = 0; i < 16; ++i) { LAS float* d = scr + (4 * i + lr) * 65 + lc; d[0] = v[i][0]; d[1] = v[i][1]; d[2] = v[i][2]; d[3] = v[i][3]; }
    LDS_WAIT(); asm volatile("" ::: "memory");
    const int c = lane & 7;
#pragma unroll
    for (int j = 0; j < 8; ++j) { const int n = (lane >> 3) + 8 * j; const LAS float* s = scr + (8 * c) * 65 + n;
        u32x4 o; o.x = pkbf(s[0 * 65], s[1 * 65]); o.y = pkbf(s[2 * 65], s[3 * 65]); o.z = pkbf(s[4 * 65], s[5 * 65]); o.w = pkbf(s[6 * 65], s[7 * 65]);
        *(u32x4*)(WT + (size_t)(n0 + n) * K + k0 + 8 * c) = o; }
    LDS_WAIT(); asm volatile("" ::: "memory");
}

__device__ __forceinline__ void phase_convert(const Params& P, LAS unsigned char* L, int gw, int ngw, int wave, int lane) {
    LAS float* scr = (LAS float*)(L + wave * 16896);
    constexpr int I_EI = 32 * 128, I_EO = 32 * 32, I_OI = 32 * 72, I_OO = 32 * 32;
    constexpr int NITEMS = 2 * (I_EI + I_EO + I_OI + I_OO);
    for (int it = gw; it < NITEMS; it += ngw) {
        int r = it;
        if (r < 2 * I_EI) { const int i = r / I_EI; r -= i * I_EI;
            transpose_item(P.in[5] + (size_t)i * DM * EVEN_IN, DM, EVEN_IN, 128, (bf16_t*)(P.ws + WS_WT_EVIN) + (size_t)i * EV_MAIN * DM, scr, r, lane); continue; }
        r -= 2 * I_EI;
        if (r < 2 * I_EO) { const int i = r / I_EO; r -= i * I_EO;
            transpose_item(P.in[6] + (size_t)i * DM * DM, DM, DM, 32, (bf16_t*)(P.ws + WS_WT_EVOUT) + (size_t)i * DM * DM, scr, r, lane); continue; }
        r -= 2 * I_EO;
        if (r < 2 * I_OI) { const int i = r / I_OI; r -= i * I_OI;
            transpose_item(P.in[16] + (size_t)i * DM * ODD_IN, DM, ODD_IN, 72, (bf16_t*)(P.ws + WS_WT_ODIN) + (size_t)i * ODD_IN * DM, scr, r, lane); continue; }
        r -= 2 * I_OI;
        { const int i = r / I_OO; r -= i * I_OO;
            transpose_item(P.in[17] + (size_t)i * DM * DM, DM, DM, 32, (bf16_t*)(P.ws + WS_WT_ODOUT) + (size_t)i * DM * DM, scr, r, lane); }
    }
    bf16_t* wtt = (bf16_t*)(P.ws + WS_WT_EVTAIL);
    for (int e = gw * 64 + lane; e < 2 * 16 * DM; e += ngw * 64) {
        const int i = e / (16 * DM), rem = e % (16 * DM), n = rem / DM, k = rem % DM;
        const float v = P.in[5][(size_t)i * DM * EVEN_IN + (size_t)k * EVEN_IN + EV_MAIN + n];
        wtt[e] = (bf16_t)(pkbf(v, 0.f) & 0xffffu);
    }
    if (gw == 0 && lane < 2) {
        const int i = lane; float s1 = 0.f, s2 = 0.f;
        for (int d = 0; d < 64; ++d) { s1 += P.in[7][i * 64 + d] * P.in[8][i * 64 + d]; s2 += P.in[9][i * 64 + d] * P.in[10][i * 64 + d]; }
        const float lam_init = (i == 0) ? 0.2f : 0.47071302f;
        ((float*)(P.ws + WS_CTL))[512 + i] = expf(s1) - expf(s2) + lam_init;
    }
}

__device__ __forceinline__ void phase_norm(const float* x, const float* nw, const float* modl, bf16_t* H, int gw, int ngw, int lane) {
    for (int row = gw; row < MROWS; row += ngw) {
        const int b = row >> 11;
        const f32x4* xr = (const f32x4*)(x + (size_t)row * DM) + lane;
        f32x4 v[8]; float s = 0.f;
#pragma unroll
        for (int j = 0; j < 8; ++j) { v[j] = xr[64 * j]; s += (v[j][0] * v[j][0] + v[j][1] * v[j][1]) + (v[j][2] * v[j][2] + v[j][3] * v[j][3]); }
        s = wave_sum(s);
        const float rstd = 1.0f / sqrtf(s * (1.f / DM) + 1e-6f);
        u32x2* o8 = (u32x2*)(H + (size_t)row * DM) + lane;
#pragma unroll
        for (int j = 0; j < 8; ++j) {
            const int col = 4 * (lane + 64 * j);
            const f32x4 w = *(const f32x4*)(nw + col), sh = *(const f32x4*)(modl + (size_t)b * 6144 + col), sc = *(const f32x4*)(modl + (size_t)b * 6144 + DM + col);
            const f32x4 h = v[j] * rstd * w * (sc + 1.0f) + sh;
            u32x2 o; o.x = pkbf(h[0], h[1]); o.y = pkbf(h[2], h[3]); o8[64 * j] = o;
        }
    }
}

__device__ __forceinline__ void phase_final(float* x, const float* nw, int gw, int ngw, int lane) {
    for (int row = gw; row < MROWS; row += ngw) {
        f32x4* xr = (f32x4*)(x + (size_t)row * DM) + lane;
        f32x4 v[8]; float s = 0.f;
#pragma unroll
        for (int j = 0; j < 8; ++j) { v[j] = xr[64 * j]; s += (v[j][0] * v[j][0] + v[j][1] * v[j][1]) + (v[j][2] * v[j][2] + v[j][3] * v[j][3]); }
        s = wave_sum(s);
        const float rstd = 1.0f / sqrtf(s * (1.f / DM) + 1e-6f);
#pragma unroll
        for (int j = 0; j < 8; ++j) { const f32x4 w = *(const f32x4*)(nw + 4 * (lane + 64 * j)); xr[64 * j] = v[j] * rstd * w; }
    }
}

__device__ __forceinline__ void phase_tail(const bf16_t* H, const bf16_t* WTt, float* TAIL, int gw, int ngw, int lane) {
#pragma unroll 1
    for (int task = gw; task < 2 * (MROWS / 16); task += ngw) {
    const int r = lane & 15, g = lane >> 4, row0 = (task & 1023) * 16, kh = task >> 10;
    const bf16_t* ap = H + (size_t)(row0 + r) * DM + kh * 1024 + 8 * g; const bf16_t* bp = WTt + (size_t)r * DM + kh * 1024 + 8 * g;
    f32x4 acc0 = {0.f, 0.f, 0.f, 0.f}, acc1 = {0.f, 0.f, 0.f, 0.f};
#pragma unroll
    for (int h2 = 0; h2 < 2; ++h2) {
        bf16x8 a[16], b[16];
#pragma unroll
        for (int s = 0; s < 16; ++s) { a[s] = *(const bf16x8*)(ap + 32 * (16 * h2 + s)); b[s] = *(const bf16x8*)(bp + 32 * (16 * h2 + s)); }
#pragma unroll
        for (int s = 0; s < 16; s += 2) { acc0 = MFMA16(a[s], b[s], acc0); acc1 = MFMA16(a[s + 1], b[s + 1], acc1); }
    }
    acc0 += acc1;
#pragma unroll
    for (int e = 0; e < 4; ++e) atomicAdd(&TAIL[(size_t)(row0 + g * 4 + e) * 16 + r], acc0[e]);
    }
}


__device__ __forceinline__ void phase_tables(const Params& P, int gw, int ngw, int lane) {
    const float* mod = (const float*)(P.ws + WS_MOD);
    float* CS = (float*)(P.ws + WS_CS); float* SHW = (float*)(P.ws + WS_SHW);
    for (int i = gw * 64 + lane; i < 3 * 8 * DM; i += ngw * 64) {
        const int l = 1 + i / (8 * DM), rem = i % (8 * DM), b = rem / DM, k = rem % DM;
        CS[i] = P.in[2][l * DM + k] * (1.0f + mod[(size_t)(l * 8 + b) * 6144 + DM + k]);
    }
    const int r = lane & 15, g = lane >> 4;
    constexpr int T1 = ODD_IN / 16, T2 = EV_MAIN / 16 + 1, T3 = ODD_IN / 16;
#pragma unroll 1
    for (int task = gw; task < T1 + T2 + T3; task += ngw) {
        int l, t; const bf16_t* wt; int nbase;
        if (task < T1) { l = 1; t = task; wt = (const bf16_t*)(P.ws + WS_WT_ODIN) + (size_t)t * 16 * DM; nbase = t * 16; }
        else if (task < T1 + T2) { l = 2; t = task - T1;
            if (t < EV_MAIN / 16) { wt = (const bf16_t*)(P.ws + WS_WT_EVIN) + (size_t)EV_MAIN * DM + (size_t)t * 16 * DM; nbase = t * 16; }
            else { wt = (const bf16_t*)(P.ws + WS_WT_EVTAIL) + (size_t)16 * DM; nbase = EV_MAIN; } }
        else { l = 3; t = task - T1 - T2; wt = (const bf16_t*)(P.ws + WS_WT_ODIN) + (size_t)ODD_IN * DM + (size_t)t * 16 * DM; nbase = t * 16; }
        const bf16_t* ap = wt + (size_t)r * DM + 8 * g;
        const float* sp = mod + (size_t)(l * 8 + (r & 7)) * 6144 + 8 * g;
        f32x4 acc = {0.f, 0.f, 0.f, 0.f};
#pragma unroll 4
        for (int s = 0; s < 64; ++s) {
            const bf16x8 a = *(const bf16x8*)(ap + 32 * s);
            const f32x4 s0 = *(const f32x4*)(sp + 32 * s), s1 = *(const f32x4*)(sp + 32 * s + 4);
            u32x4 bw; bw.x = pkbf(s0[0], s0[1]); bw.y = pkbf(s0[2], s0[3]); bw.z = pkbf(s1[0], s1[1]); bw.w = pkbf(s1[2], s1[3]);
            if (r >= 8) bw = (u32x4){0u, 0u, 0u, 0u};
            acc = MFMA16(a, __builtin_bit_cast(bf16x8, bw), acc);
        }
        if (r < 8) {
#pragma unroll
            for (int e = 0; e < 4; ++e) SHW[(size_t)((l - 1) * 8 + r) * SHW_LD + nbase + g * 4 + e] = acc[e];
        }
    }
}
__device__ __forceinline__ void phase_rstd(const Params& P, bool zero_tail, int gw, int ngw, int lane) {
    const float* ssqp = (const float*)(P.ws + WS_SSQP); float* rstd = (float*)(P.ws + WS_RSTD);
    for (int row = gw * 64 + lane; row < MROWS; row += ngw * 64) {
        const f32x4* p = (const f32x4*)(ssqp + (size_t)row * 32);
        float s = 0.f;
#pragma unroll
        for (int j = 0; j < 8; ++j) { const f32x4 v = p[j]; s += (v[0] + v[1]) + (v[2] + v[3]); }
        rstd[row] = 1.0f / sqrtf(s * (1.f / DM) + 1e-6f);
    }
    if (zero_tail) { f32x4* tz = (f32x4*)(P.ws + WS_TAIL); for (int i = gw * 64 + lane; i < MROWS * 16 / 4; i += ngw * 64) tz[i] = (f32x4){0.f, 0.f, 0.f, 0.f}; }
}

constexpr int DA_KSTR = 272, DA_VSTR = 288, DA_VOFF = 64 * DA_KSTR;
__device__ __forceinline__ void diff_attn_item(const bf16_t* PROJ, bf16_t* Y, const float* subln_w, const float* lamp, int li, int item, LAS unsigned char* L) {
    const int qb = 15 - (item >> 6), bh = item & 63, b = bh >> 3, h = bh & 7;
    const int tid = fresh_tid(), lane = tid & 63, w = __builtin_amdgcn_readfirstlane(tid >> 6), r = lane & 15, g = lane >> 4, q4 = r >> 2, p4 = lane & 3;
    const int q0 = qb * 128, ntiles = 2 * (qb + 1);
    const size_t rowbase = (size_t)b * SEQ;
    LAS unsigned char* Ks = L; LAS unsigned char* Vs = L + DA_VOFF;
    const int qpos = q0 + 16 * w + r;
    bf16x8 qf[2][2];
#pragma unroll
    for (int m = 0; m < 2; ++m)
#pragma unroll
        for (int s = 0; s < 2; ++s) qf[m][s] = *(const bf16x8*)(PROJ + (rowbase + qpos) * EV_MAIN + h * 128 + m * 64 + 32 * s + 8 * g);
    const float slope2 = exp2f(-(float)(h + 1)) * LOG2E, sc2 = 0.125f * LOG2E;
    float cb[4][4];
#pragma unroll
    for (int kb = 0; kb < 4; ++kb)
#pragma unroll
        for (int e = 0; e < 4; ++e) cb[kb][e] = -slope2 * (float)(qpos - (kb * 16 + g * 4 + e));
    f32x4 O[2][8];
#pragma unroll
    for (int m = 0; m < 2; ++m)
#pragma unroll
        for (int d = 0; d < 8; ++d) O[m][d] = (f32x4){0.f, 0.f, 0.f, 0.f};
    float mrun[2] = {-INFINITY, -INFINITY}, lrun[2] = {0.f, 0.f};
    const int lrow = tid >> 4, lc = tid & 15;
    const bf16_t* kg = PROJ + (rowbase + lrow) * EV_MAIN + 1024 + h * 128 + lc * 8;
    const bf16_t* vg = PROJ + (rowbase + lrow) * EV_MAIN + 2048 + h * 128 + lc * 8;
    u32x4 kreg[2], vreg[2];
#pragma unroll
    for (int j = 0; j < 2; ++j) { kreg[j] = *(const u32x4*)(kg + (size_t)(32 * j) * EV_MAIN); vreg[j] = *(const u32x4*)(vg + (size_t)(32 * j) * EV_MAIN); }
    for (int kt = 0; kt < ntiles; ++kt) {
        const int k0 = kt * 64;
        __syncthreads();
#pragma unroll
        for (int j = 0; j < 2; ++j) { *(LAS u32x4*)(Ks + (lrow + 32 * j) * DA_KSTR + lc * 16) = kreg[j]; *(LAS u32x4*)(Vs + (lrow + 32 * j) * DA_VSTR + lc * 16) = vreg[j]; }
        __syncthreads();
        if (kt + 1 < ntiles) {
#pragma unroll
            for (int j = 0; j < 2; ++j) { kreg[j] = *(const u32x4*)(kg + (size_t)(k0 + 64 + 32 * j) * EV_MAIN); vreg[j] = *(const u32x4*)(vg + (size_t)(k0 + 64 + 32 * j) * EV_MAIN); }
        }
        if (k0 <= q0 + 16 * w + 15) {
        f32x4 st[2][4];
#pragma unroll
        for (int m = 0; m < 2; ++m)
#pragma unroll
            for (int kb = 0; kb < 4; ++kb) { f32x4 a = {0.f, 0.f, 0.f, 0.f};
#pragma unroll
                for (int s = 0; s < 2; ++s) a = MFMA16(ld16(Ks + (kb * 16 + r) * DA_KSTR + (m * 64 + 32 * s + 8 * g) * 2), qf[m][s], a);
                st[m][kb] = a; }
        const bool diag = (k0 + 63 > q0 + 16 * w);
        const float tsh = slope2 * (float)k0;
#pragma unroll
        for (int m = 0; m < 2; ++m) {
            float tmax = -INFINITY;
            if (diag) {
#pragma unroll
                for (int kb = 0; kb < 4; ++kb)
#pragma unroll
                    for (int e = 0; e < 4; ++e) { float v = fmaf(st[m][kb][e], sc2, cb[kb][e]);
                        v = (k0 + kb * 16 + g * 4 + e > qpos) ? -INFINITY : v;
                        st[m][kb][e] = v; tmax = fmaxf(tmax, v); }
            } else {
#pragma unroll
                for (int kb = 0; kb < 4; ++kb)
#pragma unroll
                    for (int e = 0; e < 4; ++e) { const float v = fmaf(st[m][kb][e], sc2, cb[kb][e]); st[m][kb][e] = v; tmax = fmaxf(tmax, v); }
            }
            tmax = fmaxf(tmax, __shfl_xor(tmax, 16)); tmax = fmaxf(tmax, __shfl_xor(tmax, 32));
            const float cand = tmax + tsh;
            if (__any(cand > mrun[m] + 8.0f)) {
                const float mnew = fmaxf(mrun[m], cand), alpha = ex2(mrun[m] - mnew);
                mrun[m] = mnew; lrun[m] *= alpha;
#pragma unroll
                for (int d = 0; d < 8; ++d) O[m][d] *= alpha;
            }
            const float off = mrun[m] - tsh;
            float ps = 0.f;
#pragma unroll
            for (int kb = 0; kb < 4; ++kb)
#pragma unroll
                for (int e = 0; e < 4; ++e) { const float p = ex2(st[m][kb][e] - off); st[m][kb][e] = p; ps += p; }
            lrun[m] += ps;
        }
#pragma unroll
        for (int sp = 0; sp < 2; ++sp) {
            const bf16x8 pf0 = pack8(st[0][2 * sp], st[0][2 * sp + 1]), pf1 = pack8(st[1][2 * sp], st[1][2 * sp + 1]);
#pragma unroll
            for (int d = 0; d < 8; ++d) {
                const v4i16_t lo = ldtr(Vs + (32 * sp + 4 * g + q4) * DA_VSTR + (d * 16 + 4 * p4) * 2);
                const v4i16_t hi = ldtr(Vs + (32 * sp + 16 + 4 * g + q4) * DA_VSTR + (d * 16 + 4 * p4) * 2);
                const bf16x8 vf = cat8(lo, hi);
                O[0][d] = MFMA16(vf, pf0, O[0][d]); O[1][d] = MFMA16(vf, pf1, O[1][d]);
            }
        }
        }
    }
    const float lam = *lamp, one_m_li = (li == 0) ? 0.8f : 0.52928698f;
    float inv[2];
#pragma unroll
    for (int m = 0; m < 2; ++m) { float l = lrun[m]; l += __shfl_xor(l, 16); l += __shfl_xor(l, 32); inv[m] = 1.f / l; }
    float ssq = 0.f;
    const float i0 = inv[0], i1 = lam * inv[1];
#pragma unroll
    for (int d = 0; d < 8; ++d)
#pragma unroll
        for (int e = 0; e < 4; ++e) { const float o = O[0][d][e] * i0 - O[1][d][e] * i1; O[0][d][e] = o; ssq += o * o; }
    ssq += __shfl_xor(ssq, 16); ssq += __shfl_xor(ssq, 32);
    const float rn = one_m_li * rsqf(ssq * (1.f / 128.f) + 1e-6f);
    const size_t tok = rowbase + qpos;
#pragma unroll
    for (int d = 0; d < 8; ++d) {
        const int dv0 = d * 16 + g * 4;
        const u32x2 z = *(const u32x2*)(PROJ + tok * EV_MAIN + 3072 + h * 128 + dv0);
        const f32x4 sw = *(const f32x4*)(subln_w + dv0);
        const float y0 = O[0][d][0] * rn * sw[0] * siluf(bflo(z.x)), y1 = O[0][d][1] * rn * sw[1] * siluf(bfhi(z.x));
        const float y2 = O[0][d][2] * rn * sw[2] * siluf(bflo(z.y)), y3 = O[0][d][3] * rn * sw[3] * siluf(bfhi(z.y));
        u32x2 o; o.x = pkbf(y0, y1); o.y = pkbf(y2, y3);
        *(u32x2*)(Y + tok * DM + h * 128 + dv0) = o;
    }
}

constexpr int SW_KSTR = 144, SW_VSTR = 160, SW_VOFF = 256 * SW_KSTR;
__device__ __forceinline__ void swa_item(const bf16_t* PROJ, bf16_t* Y, const float* sinks, int item, LAS unsigned char* L) {
    const int b = item >> 6, qblk = (item >> 2) & 15, kvh = item & 3;
    const int tid = fresh_tid(), lane = tid & 63, w = __builtin_amdgcn_readfirstlane(tid >> 6), r = lane & 15, g = lane >> 4, q4 = r >> 2, p4 = lane & 3;
    const int q0 = qblk * 128;
    const size_t rowbase = (size_t)b * SEQ;
    LAS unsigned char* Kb = L; LAS unsigned char* Vb = L + SW_VOFF;
    const int hq = kvh * 8 + w;
    bf16x8 qc[2]; u32x2 zc[4];
    {
        const size_t tok = rowbase + q0 + r;
#pragma unroll
        for (int s = 0; s < 2; ++s) qc[s] = *(const bf16x8*)(PROJ + tok * ODD_IN + hq * 64 + 32 * s + 8 * g);
#pragma unroll
        for (int d = 0; d < 4; ++d) zc[d] = *(const u32x2*)(PROJ + tok * ODD_IN + 2560 + hq * 64 + d * 16 + g * 4);
    }
    __syncthreads();
    {
        u32x4 kv[4], vv[4];
#pragma unroll
        for (int k = 0; k < 4; ++k) {
            const int idx = tid + NTHREADS * k, key = idx >> 3, c = idx & 7, kpos = q0 - 128 + key;
            kv[k] = (u32x4){0u, 0u, 0u, 0u}; vv[k] = (u32x4){0u, 0u, 0u, 0u};
            if (kpos >= 0) { const bf16_t* src = PROJ + (rowbase + kpos) * ODD_IN + 2048 + kvh * 64 + c * 8; kv[k] = *(const u32x4*)src; vv[k] = *(const u32x4*)(src + 256); }
        }
#pragma unroll
        for (int k = 0; k < 4; ++k) {
            const int idx = tid + NTHREADS * k, key = idx >> 3, c = idx & 7;
            *(LAS u32x4*)(Kb + key * SW_KSTR + c * 16) = kv[k]; *(LAS u32x4*)(Vb + key * SW_VSTR + c * 16) = vv[k];
        }
    }
    __syncthreads();
    const float slope2 = exp2f(-(float)(hq + 1) * 0.25f) * LOG2E, sink2 = sinks[hq] * LOG2E, sc2 = 0.125f * LOG2E;
#pragma unroll 1
    for (int rb = 0; rb < 8; ++rb) {
        const int qpos = q0 + 16 * rb + r;
        const size_t tok = rowbase + qpos;
        bf16x8 qf[2], qn[2]; u32x2 zn[4];
#pragma unroll
        for (int s = 0; s < 2; ++s) { qf[s] = qc[s]; qn[s] = qc[s]; }
#pragma unroll
        for (int d = 0; d < 4; ++d) zn[d] = zc[d];
        if (rb + 1 < 8) {
            const size_t tokn = tok + 16;
#pragma unroll
            for (int s = 0; s < 2; ++s) qn[s] = *(const bf16x8*)(PROJ + tokn * ODD_IN + hq * 64 + 32 * s + 8 * g);
#pragma unroll
            for (int d = 0; d < 4; ++d) zn[d] = *(const u32x2*)(PROJ + tokn * ODD_IN + 2560 + hq * 64 + d * 16 + g * 4);
        }
        const int sb = rb < 6 ? rb : 6;
        f32x4 st[10];
        {
            bf16x8 kf[10][2];
#pragma unroll
            for (int kb = 0; kb < 10; ++kb)
#pragma unroll
                for (int s = 0; s < 2; ++s) kf[kb][s] = ld16(Kb + ((sb + kb) * 16 + r) * SW_KSTR + (32 * s + 8 * g) * 2);
            SCHED_FENCE();
#pragma unroll
            for (int kb = 0; kb < 10; ++kb) { f32x4 a = {0.f, 0.f, 0.f, 0.f};
#pragma unroll
                for (int s = 0; s < 2; ++s) a = MFMA16(kf[kb][s], qf[s], a);
                st[kb] = a; }
        }
        float tmax = -INFINITY;
#pragma unroll
        for (int kb = 0; kb < 10; ++kb)
#pragma unroll
            for (int e = 0; e < 4; ++e) { const int kpos = q0 - 128 + (sb + kb) * 16 + g * 4 + e, dist = qpos - kpos;
                float v = st[kb][e] * sc2 - slope2 * (float)dist; v = (dist >= 0 && dist < 128 && kpos >= 0) ? v : -INFINITY; st[kb][e] = v; tmax = fmaxf(tmax, v); }
        tmax = fmaxf(tmax, __shfl_xor(tmax, 16)); tmax = fmaxf(tmax, __shfl_xor(tmax, 32));
        const float mx = fmaxf(tmax, sink2);
        float ps = 0.f;
#pragma unroll
        for (int kb = 0; kb < 10; ++kb)
#pragma unroll
            for (int e = 0; e < 4; ++e) { const float p = ex2(st[kb][e] - mx); st[kb][e] = p; ps += p; }
        ps += __shfl_xor(ps, 16); ps += __shfl_xor(ps, 32);
        const float inv = 1.f / (ps + ex2(sink2 - mx));
        f32x4 O[4];
#pragma unroll
        for (int d = 0; d < 4; ++d) O[d] = (f32x4){0.f, 0.f, 0.f, 0.f};
        {
            bf16x8 vf[5][4];
#pragma unroll
            for (int sp = 0; sp < 5; ++sp)
#pragma unroll
                for (int d = 0; d < 4; ++d) {
                    const v4i16_t lo = ldtr(Vb + ((sb + 2 * sp) * 16 + 4 * g + q4) * SW_VSTR + (d * 16 + 4 * p4) * 2);
                    const v4i16_t hi = ldtr(Vb + ((sb + 2 * sp + 1) * 16 + 4 * g + q4) * SW_VSTR + (d * 16 + 4 * p4) * 2);
                    vf[sp][d] = cat8(lo, hi);
                }
            SCHED_FENCE();
#pragma unroll
            for (int sp = 0; sp < 5; ++sp) {
                const bf16x8 pf = pack8(st[2 * sp], st[2 * sp + 1]);
#pragma unroll
                for (int d = 0; d < 4; ++d) O[d] = MFMA16(vf[sp][d], pf, O[d]);
            }
        }
#pragma unroll
        for (int d = 0; d < 4; ++d) {
            const int dv0 = d * 16 + g * 4;
            const u32x2 z = zc[d];
            const float y0 = O[d][0] * inv * siluf(bflo(z.x)), y1 = O[d][1] * inv * siluf(bfhi(z.x));
            const float y2 = O[d][2] * inv * siluf(bflo(z.y)), y3 = O[d][3] * inv * siluf(bfhi(z.y));
            u32x2 o; o.x = pkbf(y0, y1); o.y = pkbf(y2, y3);
            *(u32x2*)(Y + tok * DM + hq * 64 + dv0) = o;
        }
#pragma unroll
        for (int s = 0; s < 2; ++s) qc[s] = qn[s];
#pragma unroll
        for (int d = 0; d < 4; ++d) zc[d] = zn[d];
    }
}

constexpr int GP_RAW = 0, GP_M = 0, GP_TW = 17408, GP_TU = 26624, GP_QT = 51456, GP_KT = 69888, GP_VT = 88320, GP_SM = 106752, GP_TAPS = 108800, GP_TF = 114944, GP_STR = 288, GP_TSTR = 144;
__device__ __forceinline__ void gdn_prep_load(const Params& P, int ci, int tid, u32x4 (&rv)[7], float (&tg)[2]) {
    const int bh = ci >> 5, n = ci & 31, b = bh >> 3, h = bh & 7, t0 = n * 64;
    const size_t rowbase = (size_t)b * SEQ;
    const bf16_t* PROJ = (const bf16_t*)(P.ws + WS_PROJ);
    const float* TAIL = (const float*)(P.ws + WS_TAIL);
#pragma unroll
    for (int k = 0; k < 7; ++k) {
        const int idx = tid + NTHREADS * k, rr = idx / 48, cc = idx % 48, part = cc >> 4, c16 = cc & 15, t = t0 - 3 + rr;
        rv[k] = (u32x4){0u, 0u, 0u, 0u};
        if (idx < 67 * 48 && t >= 0) rv[k] = *(const u32x4*)(PROJ + (rowbase + t) * EV_MAIN + 4096 + part * 1024 + h * 128 + c16 * 8);
    }
    { const size_t tok = rowbase + t0 + (tid & 63); tg[0] = TAIL[tok * 16 + h]; tg[1] = TAIL[tok * 16 + 8 + h]; }
}
__device__ __forceinline__ void gdn_prep_item(const Params& P, int li, int ci, int ci_next, int hprev, u32x4 (&rv)[7], float (&tg)[2], LAS unsigned char* L) {
    const int bh = ci >> 5, n = ci & 31, b = bh >> 3, h = bh & 7, t0 = n * 64;
    const int tid = fresh_tid(), lane = tid & 63, w = __builtin_amdgcn_readfirstlane(tid >> 6), r = lane & 15, g = lane >> 4, q4 = r >> 2, p4 = lane & 3;
    const size_t rowbase = (size_t)b * SEQ;
    const bf16_t* PROJ = (const bf16_t*)(P.ws + WS_PROJ);
    const float* TAIL = (const float*)(P.ws + WS_TAIL);
    LAS float* beta_s = (LAS float*)(L + GP_SM); LAS float* gc_s = beta_s + 64; LAS float* rq_s = beta_s + 128; LAS float* rk_s = beta_s + 192;
    LAS float* taps = (LAS float*)(L + GP_TAPS);
    if (h != hprev) {
        const float* cw = P.in[12] + (size_t)li * 4 * 3072 + h * 128;
        for (int idx = tid; idx < 3 * 4 * 128; idx += NTHREADS) { const int pk = idx >> 7, c = idx & 127; taps[idx] = cw[(pk & 3) * 3072 + (pk >> 2) * 1024 + c]; }
    }
    __syncthreads();
#pragma unroll
    for (int k = 0; k < 7; ++k) {
        const int idx = tid + NTHREADS * k, rr = idx / 48, cc = idx % 48;
        if (idx < 67 * 48) *(LAS u32x4*)(L + GP_RAW + rr * 768 + cc * 16) = rv[k];
    }
    float bt = tg[0], a = tg[1];
    if (li == 1) {
        const size_t tokd = rowbase + t0 + (tid & 63);
        const float rs = ((const float*)(P.ws + WS_RSTD))[tokd];
        const float* shw2 = (const float*)(P.ws + WS_SHW) + (size_t)(8 + b) * SHW_LD + EV_MAIN;
        bt = bt * rs + shw2[h]; a = a * rs + shw2[8 + h];
    }
    gdn_prep_load(P, ci_next < 2048 ? ci_next : ci, tid, rv, tg);
    if (w == 0) {
        const float xx = a + P.in[14][li * 8 + h];
        const float ee = __expf(xx);
        const float sp = xx > 20.f ? xx : (ee < 1e-3f ? ee * (1.f - 0.5f * ee) : __logf(1.f + ee));
        float gl = -__expf(P.in[13][li * 8 + h]) * sp;
#pragma unroll
        for (int o = 1; o < 64; o <<= 1) { const float v = __shfl_up(gl, o); if (lane >= o) gl += v; }
        beta_s[lane] = __builtin_amdgcn_rcpf(1.f + __expf(-bt)); gc_s[lane] = gl;
    }
    __syncthreads();
    {
#pragma unroll
        for (int part = 0; part < 3; ++part) {
            const int strip = w;
            f32x2 wvp[4];
#pragma unroll
            for (int kk = 0; kk < 4; ++kk) wvp[kk] = *(const LAS f32x2*)(taps + (part * 4 + kk) * 128 + 2 * lane);
            float x0[11], x1[11];
#pragma unroll
            for (int i = 0; i < 11; ++i) { const unsigned u = *(const LAS unsigned*)(L + GP_RAW + (strip * 8 + i) * 768 + part * 256 + lane * 4); x0[i] = bflo(u); x1[i] = bfhi(u); }
            LAS unsigned char* dst = L + (part == 0 ? GP_QT : (part == 1 ? GP_KT : GP_VT));
            float ss[8];
#pragma unroll
            for (int e = 0; e < 8; ++e) {
                float o0 = wvp[0][0] * x0[e] + wvp[1][0] * x0[e + 1] + wvp[2][0] * x0[e + 2] + wvp[3][0] * x0[e + 3];
                float o1 = wvp[0][1] * x1[e] + wvp[1][1] * x1[e + 1] + wvp[2][1] * x1[e + 2] + wvp[3][1] * x1[e + 3];
                o0 = siluf(o0); o1 = siluf(o1);
                *(LAS unsigned*)(dst + (strip * 8 + e) * GP_STR + lane * 4) = pkbf(o0, o1);
                ss[e] = o0 * o0 + o1 * o1;
            }
            if (part < 2) {
#pragma unroll
                for (int e = 0; e < 8; ++e) ss[e] = row16_sum(ss[e]);
#pragma unroll
                for (int e = 0; e < 8; ++e) ss[e] += __shfl_xor(ss[e], 16);
#pragma unroll
                for (int e = 0; e < 8; ++e) ss[e] += __shfl_xor(ss[e], 32);
                if (lane < 8) {
                    float v = ss[0];
#pragma unroll
                    for (int e = 1; e < 8; ++e) v = (lane == e) ? ss[e] : v;
                    const float rn = rsqf(v + 1e-6f);
                    if (part == 0) rq_s[strip * 8 + lane] = rn * 0.08838834764831845f; else rk_s[strip * 8 + lane] = rn;
                }
            }
        }
    }
    __syncthreads();
    {
        bf16_t* QKM = (bf16_t*)(P.ws + WS_GQK) + (size_t)ci * 4096;
        LAS float* Mm = (LAS float*)(L + GP_M);
#pragma unroll
        for (int j = 0; j < 4; ++j) {
            const int tsk = w * 4 + j, kind = tsk >> 4, bi = (tsk >> 2) & 3, bj = tsk & 3;
            const int jt = bj * 16 + r;
            const int jtp = (bj >> 1) * 32 + (r >> 2) * 8 + (bj & 1) * 4 + (r & 3);
            if (bj > bi) {
                if (kind == 1) {
#pragma unroll
                    for (int e = 0; e < 4; ++e) QKM[(bi * 16 + g * 4 + e) * 64 + jtp] = 0;
                }
            } else {
            const LAS unsigned char* Ab = L + (kind ? GP_QT : GP_KT) + (bi * 16 + r) * GP_STR + 16 * g;
            const LAS unsigned char* Bb = L + GP_KT + (bj * 16 + r) * GP_STR + 16 * g;
            f32x4 acc = {0.f, 0.f, 0.f, 0.f};
            bf16x8 fa[4], fb[4];
#pragma unroll
            for (int s = 0; s < 4; ++s) { fa[s] = ld16(Ab + 64 * s); fb[s] = ld16(Bb + 64 * s); }
#pragma unroll
            for (int s = 0; s < 4; ++s) acc = MFMA16(fa[s], fb[s], acc);
            const float rkj = rk_s[jt], gcj = gc_s[jt];
#pragma unroll
            for (int e = 0; e < 4; ++e) {
                const int it = bi * 16 + g * 4 + e;
                const float dec = ex2((gc_s[it] - gcj) * LOG2E);
                if (kind == 0) { Mm[it * 68 + jt] = (it > jt) ? beta_s[it] * rk_s[it] * rkj * acc[e] * dec : 0.f; }
                else { const float v = (it >= jt) ? rq_s[it] * rkj * acc[e] * dec : 0.f; QKM[it * 64 + jtp] = (bf16_t)(pkbf(v, 0.f) & 0xffffu); }
            }
            }
        }
    }
    __syncthreads();
    if (w == 0) {
        const LAS float* Mm = (const LAS float*)(L + GP_M);
        LAS float* TF = (LAS float*)(L + GP_TF);
        {
            float X[16];
#pragma unroll
            for (int i = 0; i < 16; ++i) {
                float acc = (i == r) ? 1.f : 0.f;
#pragma unroll
                for (int j4 = 0; j4 < (i + 3) / 4; ++j4) {
                    const f32x4 mv = *(const LAS f32x4*)(Mm + (16 * g + i) * 68 + 16 * g + 4 * j4);
#pragma unroll
                    for (int e = 0; e < 4; ++e) if (4 * j4 + e < i) acc -= mv[e] * X[4 * j4 + e];
                }
                X[i] = acc;
            }
#pragma unroll
            for (int i = 0; i < 16; ++i) TF[(16 * g + i) * 68 + 16 * g + r] = X[i];
        }
#pragma unroll
        for (int blk = 0; blk < 6; ++blk) {
            const int ba = (blk == 0) ? 1 : (blk == 1 || blk == 3) ? 2 : 3;
            const int bb = (blk == 0 || blk == 3 || blk == 5) ? 0 : (blk == 1 || blk == 4) ? 1 : 2;
            f32x4 Pm = {0.f, 0.f, 0.f, 0.f};
#pragma unroll
            for (int c = bb; c < ba; ++c) {
                const f32x4 am = *(const LAS f32x4*)(Mm + (16 * ba + r) * 68 + 16 * c + 4 * g);
#pragma unroll
                for (int s4 = 0; s4 < 4; ++s4) Pm = __builtin_amdgcn_mfma_f32_16x16x4f32(am[s4], TF[(16 * c + 4 * g + s4) * 68 + 16 * bb + r], Pm, 0, 0, 0);
            }
            const f32x4 ta = *(const LAS f32x4*)(TF + (16 * ba + r) * 68 + 16 * ba + 4 * g);
            f32x4 Rm = {0.f, 0.f, 0.f, 0.f};
#pragma unroll
            for (int s4 = 0; s4 < 4; ++s4) Rm = __builtin_amdgcn_mfma_f32_16x16x4f32(ta[s4], Pm[s4], Rm, 0, 0, 0);
#pragma unroll
            for (int e = 0; e < 4; ++e) TF[(16 * ba + 4 * g + e) * 68 + 16 * bb + r] = -Rm[e];
        }
    } else {
        bf16_t* QG = (bf16_t*)(P.ws + WS_GQG) + (size_t)ci * 8192;
        bf16_t* KD = (bf16_t*)(P.ws + WS_GKD) + (size_t)ci * 8192;
        const float gl = gc_s[63];
        for (int idx = tid - 64; idx < 2048; idx += NTHREADS - 64) {
            const int which = idx >> 10, rem = idx & 1023, t = rem >> 4, c = rem & 15;
            const u32x4 v = *(const LAS u32x4*)(L + (which ? GP_KT : GP_QT) + t * GP_STR + c * 16);
            const float sc = which ? rk_s[t] * ex2((gl - gc_s[t]) * LOG2E) : rq_s[t] * ex2(gc_s[t] * LOG2E);
            u32x4 o; o.x = pkbf(bflo(v.x) * sc, bfhi(v.x) * sc); o.y = pkbf(bflo(v.y) * sc, bfhi(v.y) * sc);
            o.z = pkbf(bflo(v.z) * sc, bfhi(v.z) * sc); o.w = pkbf(bflo(v.w) * sc, bfhi(v.w) * sc);
            if (which) *(u32x4*)(KD + t * 128 + c * 8) = o;
            else {
                const int pb = (c >> 2) * 32 + (c & 1) * 16 + ((c >> 1) & 1) * 4;
                u32x2 lo2; lo2.x = o.x; lo2.y = o.y; u32x2 hi2; hi2.x = o.z; hi2.y = o.w;
                *(u32x2*)(QG + t * 128 + pb) = lo2; *(u32x2*)(QG + t * 128 + pb + 8) = hi2;
            }
        }
        if (tid == 64) ((float*)(P.ws + WS_GGE))[ci] = ex2(gl * LOG2E);
    }
    __syncthreads();
    {
        const LAS float* TF = (const LAS float*)(L + GP_TF);
        for (int idx = tid; idx < 4096; idx += NTHREADS) {
            const int i = idx >> 6, j = idx & 63;
            const float t = ((j >> 4) > (i >> 4)) ? 0.f : TF[i * 68 + j];
            const float bj = beta_s[j], swj = bj * rk_s[j] * ex2(gc_s[j] * LOG2E);
            *(LAS bf16_t*)(L + GP_TW + i * GP_TSTR + j * 2) = (bf16_t)(pkbf(t * swj, 0.f) & 0xffffu);
            *(LAS bf16_t*)(L + GP_TU + i * GP_TSTR + j * 2) = (bf16_t)(pkbf(t * bj, 0.f) & 0xffffu);
        }
    }
    __syncthreads();
    {
        bf16_t* Wg = (bf16_t*)(P.ws + WS_GW) + (size_t)ci * 8192;
        u32x2* UT = (u32x2*)(P.ws + WS_GUT) + (size_t)ci * 2048;
#pragma unroll 2
        for (int j = 0; j < 8; ++j) {
            const int tsk = w * 8 + j;
            f32x4 acc = {0.f, 0.f, 0.f, 0.f};
            if (tsk < 32) {
                const int dkb = tsk >> 2, tb = tsk & 3, it = tb * 16 + r;
#pragma unroll
                for (int s = 0; s < 2; ++s) {
                    const v4i16_t lo = ldtr(L + GP_KT + (32 * s + 4 * g + q4) * GP_STR + (dkb * 16 + 4 * p4) * 2);
                    const v4i16_t hi = ldtr(L + GP_KT + (32 * s + 16 + 4 * g + q4) * GP_STR + (dkb * 16 + 4 * p4) * 2);
                    const v4i16_t blo = ld8(L + GP_TW + it * GP_TSTR + (32 * s + 4 * g) * 2), bhi = ld8(L + GP_TW + it * GP_TSTR + (32 * s + 16 + 4 * g) * 2);
                    acc = MFMA16(cat8(lo, hi), cat8(blo, bhi), acc);
                }
                u32x2 o; o.x = pkbf(acc[0], acc[1]); o.y = pkbf(acc[2], acc[3]);
                *(u32x2*)(Wg + it * 128 + (dkb >> 1) * 32 + g * 8 + (dkb & 1) * 4) = o;
            } else {
                const int tb = (tsk - 32) >> 3, dvb = (tsk - 32) & 7, it = tb * 16 + r;
#pragma unroll
                for (int s = 0; s < 2; ++s) {
                    const v4i16_t alo = ld8(L + GP_TU + it * GP_TSTR + (32 * s + 4 * g) * 2), ahi = ld8(L + GP_TU + it * GP_TSTR + (32 * s + 16 + 4 * g) * 2);
                    const v4i16_t lo = ldtr(L + GP_VT + (32 * s + 4 * g + q4) * GP_STR + (dvb * 16 + 4 * p4) * 2);
                    const v4i16_t hi = ldtr(L + GP_VT + (32 * s + 16 + 4 * g + q4) * GP_STR + (dvb * 16 + 4 * p4) * 2);
                    acc = MFMA16(cat8(alo, ahi), cat8(lo, hi), acc);
                }
                u32x2 o; o.x = pkbf(acc[0], acc[1]); o.y = pkbf(acc[2], acc[3]);
                UT[(tb * 8 + dvb) * 64 + lane] = o;
            }
        }
    }
}

constexpr int GS_W = 0, GS_QG = 18432, GS_KD = 36864, GS_QK = 55296, GS_SSQ = 64512, GS_STR = 288, GS_ASTR = 272, GS_QSTR = 144;
__device__ __forceinline__ void gdn_scan_item(const Params& P, int li, int bh, LAS unsigned char* L) {
    const int b = bh >> 3, h = bh & 7;
    const int tid = fresh_tid(), lane = tid & 63, w = __builtin_amdgcn_readfirstlane(tid >> 6), r = lane & 15, g = lane >> 4, q4 = r >> 2, p4 = lane & 3;
    const size_t rowbase = (size_t)b * SEQ;
    const bf16_t* PROJ = (const bf16_t*)(P.ws + WS_PROJ);
    bf16_t* Y = (bf16_t*)(P.ws + WS_HY);
    const u32x4* Wg = (const u32x4*)(P.ws + WS_GW); const u32x4* QGg = (const u32x4*)(P.ws + WS_GQG); const u32x4* KDg = (const u32x4*)(P.ws + WS_GKD);
    const u32x4* QKg = (const u32x4*)(P.ws + WS_GQK); const u32x2* UTg = (const u32x2*)(P.ws + WS_GUT); const float* GEg = (const float*)(P.ws + WS_GGE);
    const float dnw = P.in[15][li * 128 + 16 * w + r];
    LAS float* ssq_s = (LAS float*)(L + GS_SSQ);
    f32x4 S[8];
#pragma unroll
    for (int i = 0; i < 8; ++i) S[i] = (f32x4){0.f, 0.f, 0.f, 0.f};
    u32x4 pw[2], pq[2], pk[2], pqk; u32x2 pu[4]; float pge;
    {
        const size_t ci = (size_t)bh * 32;
#pragma unroll
        for (int j = 0; j < 2; ++j) { pw[j] = Wg[ci * 1024 + tid + 512 * j]; pq[j] = QGg[ci * 1024 + tid + 512 * j]; pk[j] = KDg[ci * 1024 + tid + 512 * j]; }
        pqk = QKg[ci * 512 + tid];
#pragma unroll
        for (int tb = 0; tb < 4; ++tb) pu[tb] = UTg[ci * 2048 + (tb * 8 + w) * 64 + lane];
        pge = GEg[ci];
    }
    for (int n = 0; n < 32; ++n) {
        __syncthreads();
#pragma unroll
        for (int j = 0; j < 2; ++j) { const int idx = tid + 512 * j, row = idx >> 4, c = idx & 15;
            *(LAS u32x4*)(L + GS_W + row * GS_ASTR + c * 16) = pw[j]; *(LAS u32x4*)(L + GS_QG + row * GS_ASTR + c * 16) = pq[j]; *(LAS u32x4*)(L + GS_KD + row * GS_STR + c * 16) = pk[j]; }
        *(LAS u32x4*)(L + GS_QK + (tid >> 3) * GS_QSTR + (tid & 7) * 16) = pqk;
        u32x2 puc[4];
#pragma unroll
        for (int tb = 0; tb < 4; ++tb) puc[tb] = pu[tb];
        const float ge = pge;
        __syncthreads();
        bf16x8 sb[4];
#pragma unroll
        for (int s = 0; s < 4; ++s) sb[s] = pack8(S[2 * s], S[2 * s + 1]);
        f32x4 ws[4], oq[4];
#pragma unroll
        for (int tb = 0; tb < 4; ++tb) {
            bf16x8 wf[4], qf[4];
#pragma unroll
            for (int s = 0; s < 4; ++s) {
                wf[s] = ld16(L + GS_W + (tb * 16 + r) * GS_ASTR + (32 * s + 8 * g) * 2);
                qf[s] = ld16(L + GS_QG + (tb * 16 + r) * GS_ASTR + (32 * s + 8 * g) * 2);
            }
            SCHED_FENCE();
            f32x4 a = {0.f, 0.f, 0.f, 0.f}, c = {0.f, 0.f, 0.f, 0.f};
#pragma unroll
            for (int s = 0; s < 4; ++s) { a = MFMA16(wf[s], sb[s], a); c = MFMA16(qf[s], sb[s], c); }
            ws[tb] = a; oq[tb] = c;
        }
        if (n + 1 < 32) {
            const size_t ci = (size_t)bh * 32 + n + 1;
#pragma unroll
            for (int j = 0; j < 2; ++j) { pw[j] = Wg[ci * 1024 + tid + 512 * j]; pq[j] = QGg[ci * 1024 + tid + 512 * j]; pk[j] = KDg[ci * 1024 + tid + 512 * j]; }
            pqk = QKg[ci * 512 + tid];
#pragma unroll
            for (int tb = 0; tb < 4; ++tb) pu[tb] = UTg[ci * 2048 + (tb * 8 + w) * 64 + lane];
            pge = GEg[ci];
        }
        bf16_t zr[4][4];
#pragma unroll
        for (int tb = 0; tb < 4; ++tb)
#pragma unroll
            for (int e = 0; e < 4; ++e) zr[tb][e] = PROJ[(rowbase + n * 64 + tb * 16 + g * 4 + e) * EV_MAIN + 7168 + h * 128 + 16 * w + r];
        bf16x8 vb[2];
#pragma unroll
        for (int sp = 0; sp < 2; ++sp) {
            const f32x4 u0 = {bflo(puc[2 * sp].x), bfhi(puc[2 * sp].x), bflo(puc[2 * sp].y), bfhi(puc[2 * sp].y)};
            const f32x4 u1 = {bflo(puc[2 * sp + 1].x), bfhi(puc[2 * sp + 1].x), bflo(puc[2 * sp + 1].y), bfhi(puc[2 * sp + 1].y)};
            vb[sp] = pack8(u0 - ws[2 * sp], u1 - ws[2 * sp + 1]);
        }
        {
            bf16x8 af[4][2];
#pragma unroll
            for (int tb = 0; tb < 4; ++tb)
#pragma unroll
                for (int sp = 0; sp < 2; ++sp) af[tb][sp] = ld16(L + GS_QK + (tb * 16 + r) * GS_QSTR + (32 * sp + 8 * g) * 2);
            SCHED_FENCE();
#pragma unroll
            for (int tb = 0; tb < 4; ++tb)
#pragma unroll
                for (int sp = 0; sp < 2; ++sp) oq[tb] = MFMA16(af[tb][sp], vb[sp], oq[tb]);
        }
#pragma unroll
        for (int rh = 0; rh < 2; ++rh) {
            bf16x8 kf[4][2];
#pragma unroll
            for (int rq = 0; rq < 4; ++rq)
#pragma unroll
                for (int sp = 0; sp < 2; ++sp) {
                    const int rb = rh * 4 + rq;
                    const v4i16_t lo = ldtr(L + GS_KD + (32 * sp + 4 * g + q4) * GS_STR + (rb * 16 + 4 * p4) * 2);
                    const v4i16_t hi = ldtr(L + GS_KD + (32 * sp + 16 + 4 * g + q4) * GS_STR + (rb * 16 + 4 * p4) * 2);
                    kf[rq][sp] = cat8(lo, hi);
                }
            SCHED_FENCE();
#pragma unroll
            for (int rq = 0; rq < 4; ++rq) {
                const int rb = rh * 4 + rq;
                f32x4 acc = S[rb] * ge;
#pragma unroll
                for (int sp = 0; sp < 2; ++sp) acc = MFMA16(kf[rq][sp], vb[sp], acc);
                S[rb] = acc;
            }
        }
#pragma unroll
        for (int tb = 0; tb < 4; ++tb)
#pragma unroll
            for (int e = 0; e < 4; ++e) {
                const float ss = row16_sum(oq[tb][e] * oq[tb][e]);
                if (r == 0) ssq_s[(tb * 16 + g * 4 + e) * 8 + w] = ss;
            }
        __syncthreads();
#pragma unroll
        for (int tb = 0; tb < 4; ++tb)
#pragma unroll
            for (int e = 0; e < 4; ++e) {
                const int tl = tb * 16 + g * 4 + e;
                const f32x4 t0 = *(const LAS f32x4*)(ssq_s + tl * 8), t1 = *(const LAS f32x4*)(ssq_s + tl * 8 + 4);
                const float tot = ((t0[0] + t0[1]) + (t0[2] + t0[3])) + ((t1[0] + t1[1]) + (t1[2] + t1[3]));
                const float rn = rsqf(tot * (1.f / 128.f) + 1e-6f);
                const float y = oq[tb][e] * rn * dnw * siluf(bf2f(zr[tb][e]));
                Y[(rowbase + n * 64 + tl) * DM + 1024 + h * 128 + 16 * w + r] = (bf16_t)(pkbf(y, 0.f) & 0xffffu);
            }
    }
}

#ifndef PROBE_SYNCS
#define PROBE_SYNCS 0
#endif
#ifndef PROBE_DUP
#define PROBE_DUP 0
#endif
#define PHASE_VARS const int tid = fresh_tid(), lane = tid & 63, wave = __builtin_amdgcn_readfirstlane(tid >> 6); \
    const int wg = fresh_s((int)blockIdx.x), nwg = fresh_s((int)gridDim.x), gw = wg * NWAVES + wave, ngw = nwg * NWAVES; \
    const Params P = load_params(); \
    unsigned char* ws = P.ws; (void)tid; (void)lane; (void)gw; (void)ngw; (void)ws;
__device__ __forceinline__ Params load_params() {
#if defined(__HIP_DEVICE_COMPILE__)
    typedef const __attribute__((address_space(4))) unsigned long long* KPtr;
    KPtr kp = (KPtr)__builtin_amdgcn_kernarg_segment_ptr(); asm volatile("" : "+s"(kp));
    Params p;
#pragma unroll
    for (int i = 0; i < 20; ++i) p.in[i] = (const float*)(const __attribute__((address_space(1))) float*)kp[i];
    p.out = (float*)(__attribute__((address_space(1))) float*)kp[20]; p.ws = (unsigned char*)(__attribute__((address_space(1))) unsigned char*)kp[21];
    return p;
#else
    return Params{};
#endif
}
__global__ void __launch_bounds__(NTHREADS, 2) mega_fwd(Params Parg) {
    extern __shared__ __attribute__((aligned(16))) unsigned char lds_raw[];
    LAS unsigned char* L = (LAS unsigned char*)lds_raw;
    cg::grid_group grid = cg::this_grid();
    if (fresh_s((int)gridDim.x) == 0x7ffffff) grid.sync();
    if (threadIdx.x < 8) ((LAS unsigned*)(L + XBST_OFF))[threadIdx.x] = 0u;
    __syncthreads();
    (void)xcd_barrier_post((unsigned*)(Parg.ws + WS_BAR), (volatile LAS unsigned*)(L + XBST_OFF));
#define GSYNC() do { XcdBarrier xb_; xb_.bar = (unsigned*)(load_params().ws + WS_BAR); xb_.x = xb_xcc_id(); xb_.st = (volatile LAS unsigned*)(L + XBST_OFF); xcd_barrier(xb_); } while (0)

    for (int rep = 0; rep < ((PROBE_DUP & 1) ? 2 : 1); ++rep)
    { PHASE_VARS
      __syncthreads();
      phase_mod(P, L, wg, nwg);
      __syncthreads();
      phase_convert(P, L, gw, ngw, wave, lane); }
    GSYNC();

#pragma unroll 1
    for (int layer = 0; layer < 4; ++layer) {
        { PHASE_VARS
          if (layer == 0) {
              phase_norm(P.in[0], P.in[2], (const float*)(ws + WS_MOD), (bf16_t*)(ws + WS_HY), gw, ngw, lane);
              { f32x4* tz = (f32x4*)(ws + WS_TAIL); for (int i = gw * 64 + lane; i < MROWS * 16 / 4; i += ngw * 64) tz[i] = (f32x4){0.f, 0.f, 0.f, 0.f}; }
              phase_tables(P, gw, ngw, lane);
          } else phase_rstd(P, (layer & 1) == 0, gw, ngw, lane); }
        GSYNC();
        for (int rep = 0; rep < ((PROBE_DUP & 4) ? 2 : 1); ++rep)
        { PHASE_VARS
          const int li = layer >> 1; const bool even = (layer & 1) == 0;
          const int N = even ? EV_MAIN : ODD_IN;
          const bf16_t* Bt = even ? (const bf16_t*)(ws + WS_WT_EVIN) + (size_t)li * EV_MAIN * DM : (const bf16_t*)(ws + WS_WT_ODIN) + (size_t)li * ODD_IN * DM;
          const bf16_t* Aop = (layer == 0) ? (const bf16_t*)(ws + WS_HY) : (const bf16_t*)(ws + WS_XS);
          if (even) phase_tail(Aop, (const bf16_t*)(ws + WS_WT_EVTAIL) + (size_t)li * 16 * DM, (float*)(ws + WS_TAIL), gw, ngw, lane);
          pg8::Gemm gm{Aop, Bt, MROWS, N, DM}; pg8::StaticOrder S; S.init(MROWS, N, nwg, wg);
          if (layer == 0) { pg8::EpiProj E{(bf16_t*)(ws + WS_PROJ), N}; pg8::gemm_phase<pg8::EpiProj, pg8::StaticOrder, true, true>(L, gm, S, E); }
          else { pg8::EpiProjN E{(bf16_t*)(ws + WS_PROJ), N, (const float*)(ws + WS_RSTD), (const float*)(ws + WS_SHW) + (size_t)(layer - 1) * 8 * SHW_LD};
                 pg8::gemm_phase<pg8::EpiProjN, pg8::StaticOrder, true, true>(L, gm, S, E); } }
        GSYNC();
        if ((layer & 1) == 0) {
            for (int rep = 0; rep < ((PROBE_DUP & 8) ? 2 : 1); ++rep)
            { PHASE_VARS
              const int li = layer >> 1;
              u32x4 rv[7]; float tg[2];
              gdn_prep_load(P, wg, tid, rv, tg);
              int hprev = -1;
              for (int ci = wg; ci < 2048; ci += nwg) { gdn_prep_item(P, li, ci, ci + nwg, hprev, rv, tg, L); hprev = (ci >> 5) & 7; } }
            GSYNC();
            for (int rep = 0; rep < ((PROBE_DUP & (16 | 128 | 256)) ? 2 : 1); ++rep)
            { PHASE_VARS
              const int li = (layer >> 1) + 2 * rep;
              unsigned* ctr = (unsigned*)(ws + WS_CTL) + 64 + (li & 3) * 64; LAS int* qslot = (LAS int*)(L + QSLOT_OFF);
              int qcur = (int)(xb_xcc_id() & 7u), qtried = 0;
              for (;;) {
                  __syncthreads();
                  if (tid == 0) {
                      int it = -1;
                      while (qtried < 8) {
                          const int t = (int)atomicAdd(&ctr[qcur * 8], 1u);
                          if (t < 136) { it = (t < 8) ? (qcur + 8 * t) : 64 + ((t - 8) >> 3) * 64 + qcur + 8 * ((t - 8) & 7); break; }
                          qcur = (qcur + 1) & 7; ++qtried;
                      }
                      *qslot = it;
                  }
                  __syncthreads();
                  const int item = *qslot;
                  if (item < 0) break;
                  if (item < 64) gdn_scan_item(P, li & 1, item, L);
                  else diff_attn_item((const bf16_t*)(ws + WS_PROJ), (bf16_t*)(ws + WS_HY), P.in[11] + (li & 1) * 128, (const float*)(ws + WS_CTL) + 512 + (li & 1), li & 1, item - 64, L);
              } }
        } else {
            for (int rep = 0; rep < ((PROBE_DUP & 32) ? 2 : 1); ++rep)
            { PHASE_VARS
              const int li = layer >> 1;
              for (int item = wg; item < 512; item += nwg) swa_item((const bf16_t*)(ws + WS_PROJ), (bf16_t*)(ws + WS_HY), P.in[18] + li * 32, item, L); }
        }
        GSYNC();
        for (int rep = 0; rep < (((PROBE_DUP & 64) && layer == 0) ? 2 : 1); ++rep)
        { PHASE_VARS
          const int li = layer >> 1; const bool even = (layer & 1) == 0;
          const bf16_t* Bt = even ? (const bf16_t*)(ws + WS_WT_EVOUT) + (size_t)li * DM * DM : (const bf16_t*)(ws + WS_WT_ODOUT) + (size_t)li * DM * DM;
          pg8::Gemm gm{(const bf16_t*)(ws + WS_HY), Bt, MROWS, DM, DM}; pg8::StaticOrder S; S.init(MROWS, DM, nwg, wg);
          if (layer == 3) { pg8::EpiResid E{P.out, P.out, (const float*)(ws + WS_MOD) + (size_t)layer * 8 * 6144 + 2 * DM};
              pg8::gemm_phase<pg8::EpiResid, pg8::StaticOrder, true, true>(L, gm, S, E); }
          else { pg8::EpiResid2 E{layer == 0 ? P.in[0] : P.out, P.out, (const float*)(ws + WS_MOD) + (size_t)layer * 8 * 6144 + 2 * DM,
                                  (const float*)(ws + WS_CS) + (size_t)layer * 8 * DM, (bf16_t*)(ws + WS_XS), (float*)(ws + WS_SSQP)};
              pg8::gemm_phase<pg8::EpiResid2, pg8::StaticOrder, true, true>(L, gm, S, E); } }
        GSYNC();
    }
    for (int i = 0; i < PROBE_SYNCS; ++i) GSYNC();
    { PHASE_VARS
      phase_final(P.out, P.in[19], gw, ngw, lane); }
}

extern "C" void kernel_launch(void* const* d_in, const int* in_sizes, int n_in, void* d_out, int out_size, void* d_ws, size_t ws_size, hipStream_t stream) {
    static int grid = 0;
    if (grid == 0) {
        if (n_in != 20 || out_size != MROWS * DM || ws_size < WS_END) { fprintf(stderr, "kernel_launch: unexpected shapes (n_in %d out %d ws %zu need %zu)\n", n_in, out_size, ws_size, (size_t)WS_END); grid = -1; return; }
        int dev = 0, cus = 0, per_cu = 0;
        (void)hipGetDevice(&dev);
        (void)hipDeviceGetAttribute(&cus, hipDeviceAttributeMultiprocessorCount, dev);
        if (hipFuncSetAttribute((const void*)mega_fwd, hipFuncAttributeMaxDynamicSharedMemorySize, LDS_BYTES) != hipSuccess) { fprintf(stderr, "kernel_launch: hipFuncSetAttribute failed\n"); grid = -1; return; }
        if (hipOccupancyMaxActiveBlocksPerMultiprocessor(&per_cu, (const void*)mega_fwd, NTHREADS, LDS_BYTES) != hipSuccess || per_cu < 1) { fprintf(stderr, "kernel_launch: occupancy query gave %d\n", per_cu); }
        (void)hipGetLastError();
        grid = cus > 0 ? cus : 256;
    }
    if (grid < 0) return;
    (void)hipMemsetAsync((char*)d_ws + WS_CTL, 0, CTL_BYTES, stream);
    Params p{};
    for (int i = 0; i < 20; ++i) p.in[i] = (const float*)d_in[i];
    p.out = (float*)d_out; p.ws = (unsigned char*)d_ws;
    void* args[] = {&p};
    hipError_t e = hipLaunchCooperativeKernel((const void*)mega_fwd, dim3(grid), dim3(NTHREADS), args, LDS_BYTES, stream);
    if (e != hipSuccess) fprintf(stderr, "kernel_launch: cooperative launch failed: %s (grid %d)\n", hipGetErrorString(e), grid);
}
```

```cpp
#define PROBE_SYNCS 0
#define PROBE_DUP 0
#include <hip/hip_runtime.h>
#include <hip/hip_cooperative_groups.h>
#include <cstdio>
#include <cstdint>
namespace cg = cooperative_groups;

#define LAS __attribute__((address_space(3)))
typedef unsigned short bf16_t;
typedef short bf16x8 __attribute__((ext_vector_type(8)));
typedef short v4i16_t __attribute__((ext_vector_type(4)));
typedef float f32x4 __attribute__((ext_vector_type(4)));
typedef float f32x2 __attribute__((ext_vector_type(2)));
typedef unsigned u32x4 __attribute__((ext_vector_type(4)));
typedef unsigned u32x2 __attribute__((ext_vector_type(2)));
typedef __bf16 bf16x2_t __attribute__((ext_vector_type(2)));

constexpr int DM = 2048, NB = 8, SEQ = 2048, MROWS = NB * SEQ;
constexpr int EVEN_IN = 8208, EV_MAIN = 8192, ODD_IN = 4608;
constexpr int NTHREADS = 512, NWAVES = 8;
constexpr int LDS_BYTES = 147456;
constexpr int QSLOT_OFF = LDS_BYTES - 64;
constexpr int XBST_OFF = LDS_BYTES - 32;
constexpr float LOG2E = 1.4426950408889634f;

constexpr size_t WS_CTL = 0;
constexpr size_t WS_BAR = 4096;
constexpr size_t CTL_BYTES = 32768;
constexpr size_t WS_MOD = CTL_BYTES;
constexpr size_t WS_WT_EVIN = WS_MOD + (size_t)4 * 8 * 6144 * 4;
constexpr size_t WS_WT_EVTAIL = WS_WT_EVIN + (size_t)2 * EV_MAIN * DM * 2;
constexpr size_t WS_WT_EVOUT = WS_WT_EVTAIL + (size_t)2 * 16 * DM * 2;
constexpr size_t WS_WT_ODIN = WS_WT_EVOUT + (size_t)2 * DM * DM * 2;
constexpr size_t WS_WT_ODOUT = WS_WT_ODIN + (size_t)2 * ODD_IN * DM * 2;
constexpr size_t WS_HY = WS_WT_ODOUT + (size_t)2 * DM * DM * 2;
constexpr size_t WS_PROJ = WS_HY + (size_t)MROWS * DM * 2;
constexpr size_t WS_TAIL = WS_PROJ + (size_t)MROWS * EV_MAIN * 2;
constexpr size_t WS_GW = WS_TAIL + (size_t)MROWS * 16 * 4;
constexpr size_t WS_GQG = WS_GW + (size_t)2048 * 64 * 128 * 2;
constexpr size_t WS_GKD = WS_GQG + (size_t)2048 * 64 * 128 * 2;
constexpr size_t WS_GQK = WS_GKD + (size_t)2048 * 64 * 128 * 2;
constexpr size_t WS_GUT = WS_GQK + (size_t)2048 * 64 * 64 * 2;
constexpr size_t WS_GGE = WS_GUT + (size_t)2048 * 64 * 128 * 2;
constexpr size_t WS_XS = WS_GGE + (size_t)2048 * 4;
constexpr size_t WS_SSQP = WS_XS + (size_t)MROWS * DM * 2;
constexpr size_t WS_RSTD = WS_SSQP + (size_t)MROWS * 32 * 4;
constexpr size_t WS_CS = WS_RSTD + (size_t)MROWS * 4;
constexpr int SHW_LD = 8208;
constexpr size_t WS_SHW = WS_CS + (size_t)3 * 8 * DM * 4;
constexpr size_t WS_END = WS_SHW + (size_t)3 * 8 * SHW_LD * 4;

__device__ __forceinline__ unsigned pkbf(float lo, float hi) { f32x2 v = {lo, hi}; bf16x2_t b = __builtin_convertvector(v, bf16x2_t); return __builtin_bit_cast(unsigned, b); }
__device__ __forceinline__ float bflo(unsigned u) { return __uint_as_float(u << 16); }
__device__ __forceinline__ float bfhi(unsigned u) { return __uint_as_float(u & 0xffff0000u); }
__device__ __forceinline__ float bf2f(bf16_t u) { return __uint_as_float(((unsigned)u) << 16); }
__device__ __forceinline__ float siluf(float v) { return v * __builtin_amdgcn_rcpf(1.f + __builtin_amdgcn_exp2f(-1.4426950408889634f * v)); }
__device__ __forceinline__ float rsqf(float v) { return __builtin_amdgcn_rsqf(v); }
__device__ __forceinline__ float ex2(float v) { return __builtin_amdgcn_exp2f(v); }
__device__ __forceinline__ float wave_sum(float v) {
#pragma unroll
    for (int o = 1; o < 64; o <<= 1) v += __shfl_xor(v, o);
    return v;
}
__device__ __forceinline__ float row16_sum(float v) {
    v += __builtin_bit_cast(float, __builtin_amdgcn_update_dpp(0, __builtin_bit_cast(int, v), 0x128, 0xf, 0xf, false));
    v += __builtin_bit_cast(float, __builtin_amdgcn_update_dpp(0, __builtin_bit_cast(int, v), 0x124, 0xf, 0xf, false));
    v += __builtin_bit_cast(float, __builtin_amdgcn_update_dpp(0, __builtin_bit_cast(int, v), 0x122, 0xf, 0xf, false));
    v += __builtin_bit_cast(float, __builtin_amdgcn_update_dpp(0, __builtin_bit_cast(int, v), 0x121, 0xf, 0xf, false));
    return v;
}
#define SCHED_FENCE() __builtin_amdgcn_sched_barrier(0)
__device__ __forceinline__ bf16x8 cat8(v4i16_t a, v4i16_t b) { return __builtin_shufflevector(a, b, 0, 1, 2, 3, 4, 5, 6, 7); }
__device__ __forceinline__ v4i16_t ldtr(const LAS unsigned char* p) { return __builtin_amdgcn_ds_read_tr16_b64_v4i16((LAS v4i16_t*)p); }
__device__ __forceinline__ v4i16_t ld8(const LAS unsigned char* p) { return *(const LAS v4i16_t*)p; }
__device__ __forceinline__ bf16x8 ld16(const LAS unsigned char* p) { return *(const LAS bf16x8*)p; }
__device__ __forceinline__ bf16x8 pack8(f32x4 a, f32x4 b) {
    u32x4 w; w.x = pkbf(a[0], a[1]); w.y = pkbf(a[2], a[3]); w.z = pkbf(b[0], b[1]); w.w = pkbf(b[2], b[3]);
    return __builtin_bit_cast(bf16x8, w);
}
#define MFMA16(a, b, c) __builtin_amdgcn_mfma_f32_16x16x32_bf16((a), (b), (c), 0, 0, 0)
#define LDS_WAIT() asm volatile("s_waitcnt lgkmcnt(0)" ::: "memory")
__device__ __forceinline__ int fresh_tid() { int t = threadIdx.x; asm volatile("" : "+v"(t)); return t; }
__device__ __forceinline__ int fresh_s(int v) { asm volatile("" : "+s"(v)); return v; }
template <class T> __device__ __forceinline__ T* fresh_p(T* p) { asm volatile("" : "+s"(p)); return p; }


#define XB_TMO      128
#define XB_XCNT(j)  (256  + 64 * (j))
#define XB_XSUB(j)  (1280 + 64 * (j))
#define XB_XGEN(j)  (2304 + 64 * (j))
#define XB_TOP      3328
#define XB_TOPGEN   3392
#define XCD_BAR_WORDS 3456
#define XB_SPIN_CAP (1u << 22)
__device__ __forceinline__ unsigned xb_ld(unsigned* p)              { return __hip_atomic_load(p, __ATOMIC_RELAXED, __HIP_MEMORY_SCOPE_AGENT); }
__device__ __forceinline__ unsigned xb_add(unsigned* p, unsigned v) { return __hip_atomic_fetch_add(p, v, __ATOMIC_RELAXED, __HIP_MEMORY_SCOPE_AGENT); }
__device__ __forceinline__ unsigned xb_xcc_id() { return (unsigned)__builtin_amdgcn_s_getreg((3 << 11) | 20) & 0xFu; }
#define XB_SPIN(cond, bar) do { unsigned _sp = 0; while (cond) { __builtin_amdgcn_s_sleep(1); \
    if ((++_sp & 255u) == 0u) { if (xb_ld(&(bar)[XB_TMO])) break; if (_sp > XB_SPIN_CAP) { atomicAdd(&(bar)[XB_TMO], 1u); break; } } } } while (0)
struct XcdBarrier { unsigned* bar; unsigned x; volatile LAS unsigned* st; };
__device__ __forceinline__ XcdBarrier xcd_barrier_post(unsigned* bar, volatile LAS unsigned* st) {
    XcdBarrier b; b.bar = bar; b.x = xb_xcc_id(); b.st = st;
    if (threadIdx.x == 0) (void)xb_add(&bar[XB_XCNT(b.x)], 1u);
    return b;
}
__device__ __forceinline__ void xcd_barrier_complete(unsigned* bar, unsigned x, unsigned& nloc, unsigned& nx) {
    const unsigned G = gridDim.x * gridDim.y * gridDim.z;
    unsigned sum, cnt, mine, sp = 0u;
    for (;;) {
        sum = 0u; cnt = 0u; mine = 0u;
#pragma unroll
        for (unsigned j = 0; j < 16; ++j) { const unsigned c = xb_ld(&bar[XB_XCNT(j)]); sum += c; cnt += (c > 0u) ? 1u : 0u; mine = (j == x) ? c : mine; }
        if (sum == G) break;
        __builtin_amdgcn_s_sleep(1);
        if ((++sp & 255u) == 0u) { if (xb_ld(&bar[XB_TMO])) break; if (sp > XB_SPIN_CAP) { atomicAdd(&bar[XB_TMO], 1u); break; } }
    }
    nloc = mine > 0u ? mine : 1u; nx = cnt > 0u ? cnt : 1u;
}
__device__ __forceinline__ void xcd_barrier(const XcdBarrier& b) {
    asm volatile("s_waitcnt vmcnt(0)" ::: "memory");
    __syncthreads();
    if (threadIdx.x == 0) {
        unsigned* bar = b.bar;
        __builtin_amdgcn_s_waitcnt(0);
        unsigned nloc = b.st[0], nx = b.st[1];
        if (nloc == 0u) { xcd_barrier_complete(bar, b.x, nloc, nx); b.st[0] = nloc; b.st[1] = nx; }
        const unsigned old = xb_add(&bar[XB_XSUB(b.x)], 1u);
        const unsigned gen = old / nloc;
        if (old + 1u == (gen + 1u) * nloc) {
            __builtin_amdgcn_fence(__ATOMIC_RELEASE, "agent");
            asm volatile("s_waitcnt vmcnt(0)" ::: "memory");
            const unsigned og = xb_add(&bar[XB_TOP], 1u);
            const unsigned tg = og / nx;
            if (og + 1u == (tg + 1u) * nx) xb_add(&bar[XB_TOPGEN], 1u);
            else XB_SPIN(xb_ld(&bar[XB_TOPGEN]) == tg, bar);
            __builtin_amdgcn_fence(__ATOMIC_ACQUIRE, "agent");
            xb_add(&bar[XB_XGEN(b.x)], 1u);
            asm volatile("s_waitcnt vmcnt(0)" ::: "memory");
        } else {
            XB_SPIN(xb_ld(&bar[XB_XGEN(b.x)]) == gen, bar);
            __builtin_amdgcn_fence(__ATOMIC_ACQUIRE, "agent");
            asm volatile("s_waitcnt vmcnt(0)" ::: "memory");
        }
    }
    __syncthreads();
}

namespace pg8 {
constexpr int BM = 256, BK = 64, HALF = 128, HTB = HALF * BK * 2, STAGE_BYTES = 8 * HTB, NXCD = 8, WGM = 4;
__host__ __device__ __forceinline__ int lds_byte(int r, int c) { const int st = (r >> 4) * 2 + (c >> 5), rr = r & 15, cc = c & 31, ob = rr * 64 + cc * 2; return st * 1024 + (ob ^ (((ob >> 9) & 1) << 5)); }
__host__ __device__ __forceinline__ void stage_rc(int b, int& R, int& C) { const int st = b / 1024, sb = b % 1024, swz = sb ^ (((sb >> 9) & 1) << 5); R = (st >> 1) * 16 + swz / 64; C = (st & 1) * 32 + (swz % 64) / 2; }
__host__ __device__ __forceinline__ int perm32(int rho) { const int n = rho >> 4, i = rho & 15; return 8 * (i >> 2) + 4 * n + (i & 3); }
struct Unit { int pm, pn; };
struct Gemm { const bf16_t* A; const bf16_t* Bt; int M, N, K; };
struct StaticOrder {
    int nM, nN, nwg, G, c;
    __host__ __device__ void init(int M, int N, int G_, int c_) { nM = M / BM; nN = N / BM; nwg = nM * nN; G = G_; c = c_; }
    __host__ __device__ bool next(int i, Unit& u) const {
        const long L = (long)i * G + c; if (L >= nwg) return false;
        int wgid = (int)L; { const int q = nwg / NXCD, r = nwg % NXCD, xcd = wgid % NXCD, off = wgid / NXCD; wgid = (xcd < r ? xcd * (q + 1) : r * (q + 1) + (xcd - r) * q) + off; }
        const int nig = WGM * nN, gid = wgid / nig, fm = gid * WGM, gsz = (nM - fm) < WGM ? (nM - fm) : WGM;
        u.pm = fm + ((wgid % nig) % gsz); u.pn = (wgid % nig) / gsz; return true;
    }
    __device__ __forceinline__ void a_ready(const Unit&) const {}
    __device__ __forceinline__ void done(const Unit&) const {}
};
struct EpiProj {
    static constexpr bool PERM = true, AFTER_DRAIN = false;
    bf16_t* O; int ldc;
    __device__ __forceinline__ void operator()(const f32x4 (&acc)[2][2][4][2], const Unit& u, int wr, int wc, int fr, int fq) const {
        const int row0 = u.pm * BM + wr * 64 + fr, col0 = u.pn * BM + wc * 32 + 8 * fq;
#pragma unroll
        for (int ai = 0; ai < 2; ++ai)
#pragma unroll
            for (int m = 0; m < 4; ++m) { bf16_t* rowp = O + (size_t)(row0 + ai * HALF + m * 16) * ldc + col0;
#pragma unroll
                for (int bj = 0; bj < 2; ++bj) { const f32x4 v0 = acc[ai][bj][m][0], v1 = acc[ai][bj][m][1];
                    u32x4 w; w.x = pkbf(v0[0], v0[1]); w.y = pkbf(v0[2], v0[3]); w.z = pkbf(v1[0], v1[1]); w.w = pkbf(v1[2], v1[3]);
                    *(u32x4*)(rowp + bj * HALF) = w; } }
    }
};
struct EpiResid {
    static constexpr bool PERM = true, AFTER_DRAIN = false;
    const float* xin; float* xout; const float* gate;
    __device__ __forceinline__ void operator()(const f32x4 (&acc)[2][2][4][2], const Unit& u, int wr, int wc, int fr, int fq) const {
        const int row0 = u.pm * BM + wr * 64 + fr, col0 = u.pn * BM + wc * 32 + 8 * fq;
        const int b = (u.pm * BM) >> 11;
        f32x4 gv[2][2];
#pragma unroll
        for (int bj = 0; bj < 2; ++bj)
#pragma unroll
            for (int n = 0; n < 2; ++n) gv[bj][n] = *(const f32x4*)(gate + (size_t)b * 6144 + col0 + bj * HALF + 4 * n);
        typedef const __attribute__((address_space(1))) f32x4 GF4; typedef __attribute__((address_space(1))) f32x4 GF4W;
        const __attribute__((address_space(1))) float* gxin = (const __attribute__((address_space(1))) float*)xin; __attribute__((address_space(1))) float* gxout = (__attribute__((address_space(1))) float*)xout;
        f32x4 xc[2][2], xn[2][2];
#pragma unroll
        for (int bj = 0; bj < 2; ++bj)
#pragma unroll
            for (int n = 0; n < 2; ++n) xc[bj][n] = *(const GF4*)(gxin + (size_t)row0 * DM + col0 + bj * HALF + 4 * n);
#pragma unroll
        for (int grp = 0; grp < 8; ++grp) {
            const int ai = grp >> 2, m = grp & 3;
            const size_t ro = (size_t)(row0 + ai * HALF + m * 16) * DM + col0;
            if (grp + 1 < 8) {
                const size_t rn = (size_t)(row0 + ((grp + 1) >> 2) * HALF + ((grp + 1) & 3) * 16) * DM + col0;
#pragma unroll
                for (int bj = 0; bj < 2; ++bj)
#pragma unroll
                    for (int n = 0; n < 2; ++n) xn[bj][n] = *(const GF4*)(gxin + rn + bj * HALF + 4 * n);
            }
#pragma unroll
            for (int bj = 0; bj < 2; ++bj)
#pragma unroll
                for (int n = 0; n < 2; ++n) *(GF4W*)(gxout + ro + bj * HALF + 4 * n) = xc[bj][n] + gv[bj][n] * acc[ai][bj][m][n];
#pragma unroll
            for (int bj = 0; bj < 2; ++bj)
#pragma unroll
                for (int n = 0; n < 2; ++n) xc[bj][n] = xn[bj][n];
        }
    }
};

struct EpiProjN {
    static constexpr bool PERM = true, AFTER_DRAIN = false;
    bf16_t* O; int ldc; const float* rstd; const float* shw;
    __device__ __forceinline__ void operator()(const f32x4 (&acc)[2][2][4][2], const Unit& u, int wr, int wc, int fr, int fq) const {
        const int row0 = u.pm * BM + wr * 64 + fr, col0 = u.pn * BM + wc * 32 + 8 * fq;
        const int b = (u.pm * BM) >> 11;
        f32x4 sv[2][2];
#pragma unroll
        for (int bj = 0; bj < 2; ++bj)
#pragma unroll
            for (int n = 0; n < 2; ++n) sv[bj][n] = *(const f32x4*)(shw + (size_t)b * SHW_LD + col0 + bj * HALF + 4 * n);
#pragma unroll
        for (int ai = 0; ai < 2; ++ai)
#pragma unroll
            for (int m = 0; m < 4; ++m) { const int row = row0 + ai * HALF + m * 16; const float rs = rstd[row]; bf16_t* rowp = O + (size_t)row * ldc + col0;
#pragma unroll
                for (int bj = 0; bj < 2; ++bj) { const f32x4 v0 = acc[ai][bj][m][0] * rs + sv[bj][0], v1 = acc[ai][bj][m][1] * rs + sv[bj][1];
                    u32x4 w; w.x = pkbf(v0[0], v0[1]); w.y = pkbf(v0[2], v0[3]); w.z = pkbf(v1[0], v1[1]); w.w = pkbf(v1[2], v1[3]);
                    *(u32x4*)(rowp + bj * HALF) = w; } }
    }
};
struct EpiResid2 {
    static constexpr bool PERM = true, AFTER_DRAIN = false;
    const float* xin; float* xout; const float* gate; const float* cs; bf16_t* xs; float* ssqp;
    __device__ __forceinline__ void operator()(const f32x4 (&acc)[2][2][4][2], const Unit& u, int wr, int wc, int fr, int fq) const {
        const int row0 = u.pm * BM + wr * 64 + fr, col0 = u.pn * BM + wc * 32 + 8 * fq;
        const int b = (u.pm * BM) >> 11;
        f32x4 gv[2][2], cv[2][2];
#pragma unroll
        for (int bj = 0; bj < 2; ++bj)
#pragma unroll
            for (int n = 0; n < 2; ++n) { gv[bj][n] = *(const f32x4*)(gate + (size_t)b * 6144 + col0 + bj * HALF + 4 * n); cv[bj][n] = *(const f32x4*)(cs + (size_t)b * DM + col0 + bj * HALF + 4 * n); }
        typedef const __attribute__((address_space(1))) f32x4 GF4; typedef __attribute__((address_space(1))) f32x4 GF4W;
        const __attribute__((address_space(1))) float* gxin = (const __attribute__((address_space(1))) float*)xin; __attribute__((address_space(1))) float* gxout = (__attribute__((address_space(1))) float*)xout;
        f32x4 xc[2][2], xn[2][2];
#pragma unroll
        for (int bj = 0; bj < 2; ++bj)
#pragma unroll
            for (int n = 0; n < 2; ++n) xc[bj][n] = __builtin_nontemporal_load((const GF4*)(gxin + (size_t)row0 * DM + col0 + bj * HALF + 4 * n));
#pragma unroll
        for (int grp = 0; grp < 8; ++grp) {
            const int ai = grp >> 2, m = grp & 3, row = row0 + ai * HALF + m * 16;
            const size_t ro = (size_t)row * DM + col0;
            if (grp + 1 < 8) {
                const size_t rn = (size_t)(row0 + ((grp + 1) >> 2) * HALF + ((grp + 1) & 3) * 16) * DM + col0;
#pragma unroll
                for (int bj = 0; bj < 2; ++bj)
#pragma unroll
                    for (int n = 0; n < 2; ++n) xn[bj][n] = __builtin_nontemporal_load((const GF4*)(gxin + rn + bj * HALF + 4 * n));
            }
            float ss = 0.f;
#pragma unroll
            for (int bj = 0; bj < 2; ++bj) {
                const f32x4 y0 = xc[bj][0] + gv[bj][0] * acc[ai][bj][m][0], y1 = xc[bj][1] + gv[bj][1] * acc[ai][bj][m][1];
                __builtin_nontemporal_store(y0, (GF4W*)(gxout + ro + bj * HALF)); __builtin_nontemporal_store(y1, (GF4W*)(gxout + ro + bj * HALF + 4));
                ss += (y0[0] * y0[0] + y0[1] * y0[1]) + (y0[2] * y0[2] + y0[3] * y0[3]) + (y1[0] * y1[0] + y1[1] * y1[1]) + (y1[2] * y1[2] + y1[3] * y1[3]);
                const f32x4 z0 = y0 * cv[bj][0], z1 = y1 * cv[bj][1];
                u32x4 w; w.x = pkbf(z0[0], z0[1]); w.y = pkbf(z0[2], z0[3]); w.z = pkbf(z1[0], z1[1]); w.w = pkbf(z1[2], z1[3]);
                *(u32x4*)(xs + ro + bj * HALF) = w;
            }
            ss += __shfl_xor(ss, 16); ss += __shfl_xor(ss, 32);
            if (fq == 0) ssqp[(size_t)row * 32 + u.pn * 4 + wc] = ss;
#pragma unroll
            for (int bj = 0; bj < 2; ++bj)
#pragma unroll
                for (int n = 0; n < 2; ++n) xc[bj][n] = xn[bj][n];
        }
    }
};
#define PG8_LAS LAS
template <class Epi, class Sched, bool ALIGN_EPI = false, bool SP2 = false>
__device__ __forceinline__ void gemm_phase(PG8_LAS unsigned char* lds, const Gemm g, const Sched& S, const Epi& E) {
    const int tid = fresh_tid(), wid = __builtin_amdgcn_readfirstlane(tid >> 6), lane = tid & 63, wr = wid >> 2, wc = wid & 3, fr = lane & 15, fq = lane >> 4;
    const int K = g.K, nt = K / BK;
    unsigned voffA[2], voffB[2];
#pragma unroll
    for (int i = 0; i < 2; ++i) { int R, C; stage_rc(tid * 16 + i * 8192, R, C); const int Rb = Epi::PERM ? ((R & ~31) + perm32(R & 31)) : R;
        voffA[i] = (unsigned)(R * K + C) * 2u; voffB[i] = (unsigned)(Rb * K + C) * 2u; }
    const size_t kstep = (size_t)(BK * 2);
    const size_t hstep = (size_t)HALF * K * 2;
    const size_t tstep = 2 * hstep;
    const unsigned ldsw = (unsigned)wid * 1024u;
    const int aoff = lds_byte(wr * 64 + fr, fq * 8), boff = lds_byte(wc * 32 + fr, fq * 8);
#define PG8_SA(b, h) (((b) * 2 + (h)) * HTB)
#define PG8_SB(b, h) ((4 + (b) * 2 + (h)) * HTB)
#define PG8_STAGE(bufoff, gbase, voff) do { _Pragma("unroll") for (int _i = 0; _i < 2; ++_i) \
        __builtin_amdgcn_global_load_lds((const unsigned*)((const char*)(gbase) + (voff)[_i]), (PG8_LAS unsigned*)(lds + (bufoff) + ldsw + _i * 8192), 16, 0, 0); } while (0)
#define PG8_LDA(dst, b, h) do { _Pragma("unroll") for (int m = 0; m < 4; ++m) _Pragma("unroll") for (int k = 0; k < 2; ++k) dst[m][k] = *(const PG8_LAS bf16x8*)(lds + PG8_SA(b, h) + aoff + m * 2048 + k * 1024); } while (0)
#define PG8_LDB(dst, b, h) do { _Pragma("unroll") for (int n = 0; n < 2; ++n) _Pragma("unroll") for (int k = 0; k < 2; ++k) dst[n][k] = *(const PG8_LAS bf16x8*)(lds + PG8_SB(b, h) + boff + n * 2048 + k * 1024); } while (0)
#define PG8_MMA(ai, bj, At, Bt) do { __builtin_amdgcn_s_setprio(1); _Pragma("unroll") for (int m = 0; m < 4; ++m) _Pragma("unroll") for (int n = 0; n < 2; ++n) _Pragma("unroll") for (int k = 0; k < 2; ++k) \
        acc[ai][bj][m][n] = __builtin_amdgcn_mfma_f32_16x16x32_bf16(Bt[n][k], At[m][k], acc[ai][bj][m][n], 0, 0, 0); __builtin_amdgcn_s_setprio(0); } while (0)
#define PG8_WAIT_V(n) asm volatile("s_waitcnt vmcnt(" #n ")" ::: "memory")
#define PG8_WAIT_L(n) asm volatile("s_waitcnt lgkmcnt(" #n ")" ::: "memory")
#define PG8_BAR __builtin_amdgcn_s_barrier()
#define PG8_SCHED __builtin_amdgcn_sched_barrier(0)
    Unit cur, nxt; int ui = 0;
    if (!S.next(0, cur)) return;
    f32x4 acc[2][2][4][2];
#pragma unroll
    for (int a = 0; a < 2; ++a)
#pragma unroll
        for (int b = 0; b < 2; ++b)
#pragma unroll
            for (int m = 0; m < 4; ++m)
#pragma unroll
                for (int n = 0; n < 2; ++n) acc[a][b][m][n] = (f32x4){0.f, 0.f, 0.f, 0.f};
    bf16x8 At[4][2], B0[2][2], B1[2][2];
    const char* cA = (const char*)g.A + (size_t)cur.pm * tstep; const char* cB = (const char*)g.Bt + (size_t)cur.pn * tstep;
    S.a_ready(cur);
    if constexpr (SP2) {
        PG8_STAGE(PG8_SB(0, 0), cB, voffB); PG8_STAGE(PG8_SB(0, 1), cB + hstep, voffB); PG8_STAGE(PG8_SA(0, 0), cA, voffA); PG8_STAGE(PG8_SA(0, 1), cA + hstep, voffA);
        if (wr == 1) PG8_BAR;
        PG8_WAIT_V(2); PG8_BAR;
        PG8_STAGE(PG8_SB(1, 0), cB + kstep, voffB); PG8_STAGE(PG8_SA(1, 0), cA + kstep, voffA); PG8_STAGE(PG8_SB(1, 1), cB + hstep + kstep, voffB);
        PG8_WAIT_V(6); PG8_BAR;
    } else {
        PG8_STAGE(PG8_SB(0, 0), cB, voffB); PG8_STAGE(PG8_SA(0, 0), cA, voffA); PG8_STAGE(PG8_SB(0, 1), cB + hstep, voffB); PG8_STAGE(PG8_SA(0, 1), cA + hstep, voffA);
        if (wr == 1) PG8_BAR;
        PG8_WAIT_V(4); PG8_BAR;
        PG8_STAGE(PG8_SB(1, 0), cB + kstep, voffB); PG8_STAGE(PG8_SA(1, 0), cA + kstep, voffA); PG8_STAGE(PG8_SB(1, 1), cB + hstep + kstep, voffB);
        PG8_WAIT_V(6); PG8_BAR;
    }
    for (;;) {
        const bool has_next = S.next(ui + 1, nxt);
        const char* nA = has_next ? (const char*)g.A + (size_t)nxt.pm * tstep : cA; const char* nB = has_next ? (const char*)g.Bt + (size_t)nxt.pn * tstep : cB;
        for (int t = 0; t < nt; t += 2) {
            const bool last = (t == nt - 2);
            const char* a1 = cA + (size_t)(t + 1) * kstep;
            const char* a2 = last ? nA : cA + (size_t)(t + 2) * kstep; const char* b2 = last ? nB : cB + (size_t)(t + 2) * kstep;
            const char* a3 = a2 + kstep; const char* b3 = b2 + kstep;
            if (last && has_next) S.a_ready(nxt);
            if constexpr (SP2) {
            PG8_LDB(B0, 0, 0); PG8_LDB(B1, 0, 1); PG8_SCHED; PG8_LDA(At, 0, 0); PG8_STAGE(PG8_SA(1, 1), a1 + hstep, voffA);
            PG8_WAIT_V(8); PG8_WAIT_L(0); PG8_BAR; PG8_MMA(0, 0, At, B0); PG8_MMA(0, 1, At, B1); PG8_BAR; PG8_SCHED;
            PG8_LDA(At, 0, 1); PG8_STAGE(PG8_SB(0, 0), b2, voffB); PG8_STAGE(PG8_SB(0, 1), b2 + hstep, voffB); PG8_STAGE(PG8_SA(0, 0), a2, voffA);
            PG8_WAIT_V(8); PG8_WAIT_L(0); PG8_BAR; PG8_MMA(1, 0, At, B0); PG8_MMA(1, 1, At, B1); PG8_BAR; PG8_SCHED;
            PG8_LDB(B0, 1, 0); PG8_LDB(B1, 1, 1); PG8_SCHED; PG8_LDA(At, 1, 0); PG8_STAGE(PG8_SA(0, 1), a2 + hstep, voffA);
            PG8_WAIT_V(8); PG8_WAIT_L(0); PG8_BAR; PG8_MMA(0, 0, At, B0); PG8_MMA(0, 1, At, B1); PG8_BAR; PG8_SCHED;
            PG8_LDA(At, 1, 1); PG8_STAGE(PG8_SB(1, 0), b3, voffB); PG8_STAGE(PG8_SB(1, 1), b3 + hstep, voffB); PG8_STAGE(PG8_SA(1, 0), a3, voffA);
            PG8_WAIT_V(8); PG8_WAIT_L(0); PG8_BAR; PG8_MMA(1, 0, At, B0); PG8_MMA(1, 1, At, B1); PG8_BAR; PG8_SCHED;
            } else {
            PG8_LDB(B0, 0, 0); PG8_SCHED; PG8_LDA(At, 0, 0); PG8_STAGE(PG8_SA(1, 1), a1 + hstep, voffA);
            PG8_WAIT_L(8); PG8_BAR; PG8_WAIT_L(0); PG8_MMA(0, 0, At, B0); PG8_BAR; PG8_SCHED;
            PG8_LDB(B1, 0, 1); PG8_STAGE(PG8_SB(0, 0), b2, voffB);
            PG8_BAR; PG8_WAIT_L(0); PG8_MMA(0, 1, At, B1); PG8_BAR;
            PG8_LDA(At, 0, 1); PG8_STAGE(PG8_SA(0, 0), a2, voffA);
            PG8_BAR; PG8_WAIT_L(0); PG8_MMA(1, 0, At, B0); PG8_BAR; PG8_SCHED;
            PG8_STAGE(PG8_SB(0, 1), b2 + hstep, voffB);
            PG8_WAIT_V(6); PG8_BAR; PG8_MMA(1, 1, At, B1); PG8_BAR;
            PG8_LDB(B0, 1, 0); PG8_SCHED; PG8_LDA(At, 1, 0); PG8_STAGE(PG8_SA(0, 1), a2 + hstep, voffA);
            PG8_WAIT_L(8); PG8_BAR; PG8_WAIT_L(0); PG8_MMA(0, 0, At, B0); PG8_BAR; PG8_SCHED;
            PG8_LDB(B1, 1, 1); PG8_STAGE(PG8_SB(1, 0), b3, voffB);
            PG8_BAR; PG8_WAIT_L(0); PG8_MMA(0, 1, At, B1); PG8_BAR;
            PG8_LDA(At, 1, 1); PG8_STAGE(PG8_SA(1, 0), a3, voffA);
            PG8_BAR; PG8_WAIT_L(0); PG8_MMA(1, 0, At, B0); PG8_BAR; PG8_SCHED;
            PG8_STAGE(PG8_SB(1, 1), b3 + hstep, voffB);
            PG8_WAIT_V(6); PG8_BAR; PG8_MMA(1, 1, At, B1); PG8_BAR;
            }
        }
        if constexpr (ALIGN_EPI) { if (wr == 0) PG8_BAR; }
        if constexpr (!Epi::AFTER_DRAIN) { E(acc, cur, wr, wc, fr, fq); S.done(cur); }
        if (!has_next) break;
#pragma unroll
        for (int a = 0; a < 2; ++a)
#pragma unroll
            for (int b = 0; b < 2; ++b)
#pragma unroll
                for (int m = 0; m < 4; ++m)
#pragma unroll
                    for (int n = 0; n < 2; ++n) acc[a][b][m][n] = (f32x4){0.f, 0.f, 0.f, 0.f};
        cur = nxt; cA = nA; cB = nB; ++ui;
        if constexpr (ALIGN_EPI) { if (wr == 1) PG8_BAR; }
    }
    PG8_WAIT_V(0);
    if constexpr (!ALIGN_EPI) { if (wr == 0) PG8_BAR; }
    PG8_BAR;
    if constexpr (Epi::AFTER_DRAIN) { E.fused(acc, cur, wr, wc, fr, fq, lds, wid, lane); S.done(cur); }
#undef PG8_SA
#undef PG8_SB
#undef PG8_STAGE
#undef PG8_LDA
#undef PG8_LDB
#undef PG8_MMA
#undef PG8_WAIT_V
#undef PG8_WAIT_L
#undef PG8_BAR
#undef PG8_SCHED
}
}

struct Params {
    const float* in[20];
    float* out;
    unsigned char* ws;
};

__device__ __forceinline__ void phase_mod(const Params& P, LAS unsigned char* L, int wg, int nwg) {
    LAS float* cond = (LAS float*)L;
    LAS float* red = (LAS float*)(L + 65536);
    const int tid = fresh_tid();
    const float* c = P.in[1]; const float* ada_w = P.in[3]; const float* ada_b = P.in[4];
    float* mod = (float*)(P.ws + WS_MOD);
    for (int i = tid; i < 8 * 2048; i += NTHREADS) { const float v = c[i]; cond[i] = v / (1.f + expf(-v)); }
    __syncthreads();
    const int cl = tid & 7, kg = tid >> 3;
    for (int item = wg; item < 768; item += nwg) {
        const int l = item / 192, cgp = item % 192;
        const float* W = ada_w + (size_t)l * 2048 * 6144 + cgp * 32 + cl * 4;
        f32x4 acc[8];
#pragma unroll
        for (int b = 0; b < 8; ++b) acc[b] = (f32x4){0.f, 0.f, 0.f, 0.f};
#pragma unroll 8
        for (int kk = 0; kk < 32; ++kk) {
            const int k = kk * 64 + kg;
            const f32x4 w = *(const f32x4*)(W + (size_t)k * 6144);
#pragma unroll
            for (int b = 0; b < 8; ++b) acc[b] += w * cond[b * 2048 + k];
        }
#pragma unroll
        for (int b = 0; b < 8; ++b) *(LAS f32x4*)(red + kg * 256 + b * 32 + cl * 4) = acc[b];
        __syncthreads();
        if (tid < 256) {
            float s = 0.f;
#pragma unroll 8
            for (int k2 = 0; k2 < 64; ++k2) s += red[k2 * 256 + tid];
            const int b = tid >> 5, cc = tid & 31, n = cgp * 32 + cc;
            mod[(size_t)(l * 8 + b) * 6144 + n] = s + ada_b[l * 6144 + n];
        }
        __syncthreads();
    }
}

__device__ __forceinline__ void transpose_item(const float* W, int K, int ldw, int nblk, bf16_t* WT, LAS float* scr, int item, int lane) {
    const int kb = item / nblk, nb = item % nblk, k0 = 64 * kb, n0 = 64 * nb;
    const int lr = lane >> 4, lc = (lane & 15) * 4;
    f32x4 v[16];
#pragma unroll
    for (int i = 0; i < 16; ++i) v[i] = *(const f32x4*)(W + (size_t)(k0 + 4 * i + lr) * ldw + n0 + lc);
#pragma unroll
    for (int i = 0; i < 16; ++i) { LAS float* d = scr + (4 * i + lr) * 65 + lc; d[0] = v[i][0]; d[1] = v[i][1]; d[2] = v[i][2]; d[3] = v[i][3]; }
    LDS_WAIT(); asm volatile("" ::: "memory");
    const int c = lane & 7;
#pragma unroll
    for (int j = 0; j < 8; ++j) { const int n = (lane >> 3) + 8 * j; const LAS float* s = scr + (8 * c) * 65 + n;
        u32x4 o; o.x = pkbf(s[0 * 65], s[1 * 65]); o.y = pkbf(s[2 * 65], s[3 * 65]); o.z = pkbf(s[4 * 65], s[5 * 65]); o.w = pkbf(s[6 * 65], s[7 * 65]);
        *(u32x4*)(WT + (size_t)(n0 + n) * K + k0 + 8 * c) = o; }
    LDS_WAIT(); asm volatile("" ::: "memory");
}

__device__ __forceinline__ void phase_convert(const Params& P, LAS unsigned char* L, int gw, int ngw, int wave, int lane) {
    LAS float* scr = (LAS float*)(L + wave * 16896);
    constexpr int I_EI = 32 * 128, I_EO = 32 * 32, I_OI = 32 * 72, I_OO = 32 * 32;
    constexpr int NITEMS = 2 * (I_EI + I_EO + I_OI + I_OO);
    for (int it = gw; it < NITEMS; it += ngw) {
        int r = it;
        if (r < 2 * I_EI) { const int i = r / I_EI; r -= i * I_EI;
            transpose_item(P.in[5] + (size_t)i * DM * EVEN_IN, DM, EVEN_IN, 128, (bf16_t*)(P.ws + WS_WT_EVIN) + (size_t)i * EV_MAIN * DM, scr, r, lane); continue; }
        r -= 2 * I_EI;
        if (r < 2 * I_EO) { const int i = r / I_EO; r -= i * I_EO;
            transpose_item(P.in[6] + (size_t)i * DM * DM, DM, DM, 32, (bf16_t*)(P.ws + WS_WT_EVOUT) + (size_t)i * DM * DM, scr, r, lane); continue; }
        r -= 2 * I_EO;
        if (r < 2 * I_OI) { const int i = r / I_OI; r -= i * I_OI;
            transpose_item(P.in[16] + (size_t)i * DM * ODD_IN, DM, ODD_IN, 72, (bf16_t*)(P.ws + WS_WT_ODIN) + (size_t)i * ODD_IN * DM, scr, r, lane); continue; }
        r -= 2 * I_OI;
        { const int i = r / I_OO; r -= i * I_OO;
            transpose_item(P.in[17] + (size_t)i * DM * DM, DM, DM, 32, (bf16_t*)(P.ws + WS_WT_ODOUT) + (size_t)i * DM * DM, scr, r, lane); }
    }
    bf16_t* wtt = (bf16_t*)(P.ws + WS_WT_EVTAIL);
    for (int e = gw * 64 + lane; e < 2 * 16 * DM; e += ngw * 64) {
        const int i = e / (16 * DM), rem = e % (16 * DM), n = rem / DM, k = rem % DM;
        const float v = P.in[5][(size_t)i * DM * EVEN_IN + (size_t)k * EVEN_IN + EV_MAIN + n];
        wtt[e] = (bf16_t)(pkbf(v, 0.f) & 0xffffu);
    }
    if (gw == 0 && lane < 2) {
        const int i = lane; float s1 = 0.f, s2 = 0.f;
        for (int d = 0; d < 64; ++d) { s1 += P.in[7][i * 64 + d] * P.in[8][i * 64 + d]; s2 += P.in[9][i * 64 + d] * P.in[10][i * 64 + d]; }
        const float lam_init = (i == 0) ? 0.2f : 0.47071302f;
        ((float*)(P.ws + WS_CTL))[512 + i] = expf(s1) - expf(s2) + lam_init;
    }
}

__device__ __forceinline__ void phase_norm(const float* x, const float* nw, const float* modl, bf16_t* H, int gw, int ngw, int lane) {
    for (int row = gw; row < MROWS; row += ngw) {
        const int b = row >> 11;
        const f32x4* xr = (const f32x4*)(x + (size_t)row * DM) + lane;
        f32x4 v[8]; float s = 0.f;
#pragma unroll
        for (int j = 0; j < 8; ++j) { v[j] = xr[64 * j]; s += (v[j][0] * v[j][0] + v[j][1] * v[j][1]) + (v[j][2] * v[j][2] + v[j][3] * v[j][3]); }
        s = wave_sum(s);
        const float rstd = 1.0f / sqrtf(s * (1.f / DM) + 1e-6f);
        u32x2* o8 = (u32x2*)(H + (size_t)row * DM) + lane;
#pragma unroll
        for (int j = 0; j < 8; ++j) {
            const int col = 4 * (lane + 64 * j);
            const f32x4 w = *(const f32x4*)(nw + col), sh = *(const f32x4*)(modl + (size_t)b * 6144 + col), sc = *(const f32x4*)(modl + (size_t)b * 6144 + DM + col);
            const f32x4 h = v[j] * rstd * w * (sc + 1.0f) + sh;
            u32x2 o; o.x = pkbf(h[0], h[1]); o.y = pkbf(h[2], h[3]); o8[64 * j] = o;
        }
    }
}

__device__ __forceinline__ void phase_final(float* x, const float* nw, int gw, int ngw, int lane) {
    for (int row = gw; row < MROWS; row += ngw) {
        f32x4* xr = (f32x4*)(x + (size_t)row * DM) + lane;
        f32x4 v[8]; float s = 0.f;
#pragma unroll
        for (int j = 0; j < 8; ++j) { v[j] = xr[64 * j]; s += (v[j][0] * v[j][0] + v[j][1] * v[j][1]) + (v[j][2] * v[j][2] + v[j][3] * v[j][3]); }
        s = wave_sum(s);
        const float rstd = 1.0f / sqrtf(s * (1.f / DM) + 1e-6f);
#pragma unroll
        for (int j = 0; j < 8; ++j) { const f32x4 w = *(const f32x4*)(nw + 4 * (lane + 64 * j)); xr[64 * j] = v[j] * rstd * w; }
    }
}

__device__ __forceinline__ void phase_tail(const bf16_t* H, const bf16_t* WTt, float* TAIL, int gw, int ngw, int lane) {
#pragma unroll 1
    for (int task = gw; task < 2 * (MROWS / 16); task += ngw) {
    const int r = lane & 15, g = lane >> 4, row0 = (task & 1023) * 16, kh = task >> 10;
    const bf16_t* ap = H + (size_t)(row0 + r) * DM + kh * 1024 + 8 * g; const bf16_t* bp = WTt + (size_t)r * DM + kh * 1024 + 8 * g;
    f32x4 acc0 = {0.f, 0.f, 0.f, 0.f}, acc1 = {0.f, 0.f, 0.f, 0.f};
#pragma unroll
    for (int h2 = 0; h2 < 2; ++h2) {
        bf16x8 a[16], b[16];
#pragma unroll
        for (int s = 0; s < 16; ++s) { a[s] = *(const bf16x8*)(ap + 32 * (16 * h2 + s)); b[s] = *(const bf16x8*)(bp + 32 * (16 * h2 + s)); }
#pragma unroll
        for (int s = 0; s < 16; s += 2) { acc0 = MFMA16(a[s], b[s], acc0); acc1 = MFMA16(a[s + 1], b[s + 1], acc1); }
    }
    acc0 += acc1;
#pragma unroll
    for (int e = 0; e < 4; ++e) atomicAdd(&TAIL[(size_t)(row0 + g * 4 + e) * 16 + r], acc0[e]);
    }
}


__device__ __forceinline__ void phase_tables(const Params& P, int gw, int ngw, int lane) {
    const float* mod = (const float*)(P.ws + WS_MOD);
    float* CS = (float*)(P.ws + WS_CS); float* SHW = (float*)(P.ws + WS_SHW);
    for (int i = gw * 64 + lane; i < 3 * 8 * DM; i += ngw * 64) {
        const int l = 1 + i / (8 * DM), rem = i % (8 * DM), b = rem / DM, k = rem % DM;
        CS[i] = P.in[2][l * DM + k] * (1.0f + mod[(size_t)(l * 8 + b) * 6144 + DM + k]);
    }
    const int r = lane & 15, g = lane >> 4;
    constexpr int T1 = ODD_IN / 16, T2 = EV_MAIN / 16 + 1, T3 = ODD_IN / 16;
#pragma unroll 1
    for (int task = gw; task < T1 + T2 + T3; task += ngw) {
        int l, t; const bf16_t* wt; int nbase;
        if (task < T1) { l = 1; t = task; wt = (const bf16_t*)(P.ws + WS_WT_ODIN) + (size_t)t * 16 * DM; nbase = t * 16; }
        else if (task < T1 + T2) { l = 2; t = task - T1;
            if (t < EV_MAIN / 16) { wt = (const bf16_t*)(P.ws + WS_WT_EVIN) + (size_t)EV_MAIN * DM + (size_t)t * 16 * DM; nbase = t * 16; }
            else { wt = (const bf16_t*)(P.ws + WS_WT_EVTAIL) + (size_t)16 * DM; nbase = EV_MAIN; } }
        else { l = 3; t = task - T1 - T2; wt = (const bf16_t*)(P.ws + WS_WT_ODIN) + (size_t)ODD_IN * DM + (size_t)t * 16 * DM; nbase = t * 16; }
        const bf16_t* ap = wt + (size_t)r * DM + 8 * g;
        const float* sp = mod + (size_t)(l * 8 + (r & 7)) * 6144 + 8 * g;
        f32x4 acc = {0.f, 0.f, 0.f, 0.f};
#pragma unroll 4
        for (int s = 0; s < 64; ++s) {
            const bf16x8 a = *(const bf16x8*)(ap + 32 * s);
            const f32x4 s0 = *(const f32x4*)(sp + 32 * s), s1 = *(const f32x4*)(sp + 32 * s + 4);
            u32x4 bw; bw.x = pkbf(s0[0], s0[1]); bw.y = pkbf(s0[2], s0[3]); bw.z = pkbf(s1[0], s1[1]); bw.w = pkbf(s1[2], s1[3]);
            if (r >= 8) bw = (u32x4){0u, 0u, 0u, 0u};
            acc = MFMA16(a, __builtin_bit_cast(bf16x8, bw), acc);
        }
        if (r < 8) {
#pragma unroll
            for (int e = 0; e < 4; ++e) SHW[(size_t)((l - 1) * 8 + r) * SHW_LD + nbase + g * 4 + e] = acc[e];
        }
    }
}
__device__ __forceinline__ void phase_rstd(const Params& P, bool zero_tail, int gw, int ngw, int lane) {
    const float* ssqp = (const float*)(P.ws + WS_SSQP); float* rstd = (float*)(P.ws + WS_RSTD);
    for (int row = gw * 64 + lane; row < MROWS; row += ngw * 64) {
        const f32x4* p = (const f32x4*)(ssqp + (size_t)row * 32);
        float s = 0.f;
#pragma unroll
        for (int j = 0; j < 8; ++j) { const f32x4 v = p[j]; s += (v[0] + v[1]) + (v[2] + v[3]); }
        rstd[row] = 1.0f / sqrtf(s * (1.f / DM) + 1e-6f);
    }
    if (zero_tail) { f32x4* tz = (f32x4*)(P.ws + WS_TAIL); for (int i = gw * 64 + lane; i < MROWS * 16 / 4; i += ngw * 64) tz[i] = (f32x4){0.f, 0.f, 0.f, 0.f}; }
}

constexpr int DA_KSTR = 272, DA_VSTR = 288, DA_VOFF = 64 * DA_KSTR;
__device__ __forceinline__ void diff_attn_item(const bf16_t* PROJ, bf16_t* Y, const float* subln_w, const float* lamp, int li, int item, LAS unsigned char* L) {
    const int qb = 15 - (item >> 6), bh = item & 63, b = bh >> 3, h = bh & 7;
    const int tid = fresh_tid(), lane = tid & 63, w = __builtin_amdgcn_readfirstlane(tid >> 6), r = lane & 15, g = lane >> 4, q4 = r >> 2, p4 = lane & 3;
    const int q0 = qb * 128, ntiles = 2 * (qb + 1);
    const size_t rowbase = (size_t)b * SEQ;
    LAS unsigned char* Ks = L; LAS unsigned char* Vs = L + DA_VOFF;
    const int qpos = q0 + 16 * w + r;
    bf16x8 qf[2][2];
#pragma unroll
    for (int m = 0; m < 2; ++m)
#pragma unroll
        for (int s = 0; s < 2; ++s) qf[m][s] = *(const bf16x8*)(PROJ + (rowbase + qpos) * EV_MAIN + h * 128 + m * 64 + 32 * s + 8 * g);
    const float slope2 = exp2f(-(float)(h + 1)) * LOG2E, sc2 = 0.125f * LOG2E;
    float cb[4][4];
#pragma unroll
    for (int kb = 0; kb < 4; ++kb)
#pragma unroll
        for (int e = 0; e < 4; ++e) cb[kb][e] = -slope2 * (float)(qpos - (kb * 16 + g * 4 + e));
    f32x4 O[2][8];
#pragma unroll
    for (int m = 0; m < 2; ++m)
#pragma unroll
        for (int d = 0; d < 8; ++d) O[m][d] = (f32x4){0.f, 0.f, 0.f, 0.f};
    float mrun[2] = {-INFINITY, -INFINITY}, lrun[2] = {0.f, 0.f};
    const int lrow = tid >> 4, lc = tid & 15;
    const bf16_t* kg = PROJ + (rowbase + lrow) * EV_MAIN + 1024 + h * 128 + lc * 8;
    const bf16_t* vg = PROJ + (rowbase + lrow) * EV_MAIN + 2048 + h * 128 + lc * 8;
    u32x4 kreg[2], vreg[2];
#pragma unroll
    for (int j = 0; j < 2; ++j) { kreg[j] = *(const u32x4*)(kg + (size_t)(32 * j) * EV_MAIN); vreg[j] = *(const u32x4*)(vg + (size_t)(32 * j) * EV_MAIN); }
    for (int kt = 0; kt < ntiles; ++kt) {
        const int k0 = kt * 64;
        __syncthreads();
#pragma unroll
        for (int j = 0; j < 2; ++j) { *(LAS u32x4*)(Ks + (lrow + 32 * j) * DA_KSTR + lc * 16) = kreg[j]; *(LAS u32x4*)(Vs + (lrow + 32 * j) * DA_VSTR + lc * 16) = vreg[j]; }
        __syncthreads();
        if (kt + 1 < ntiles) {
#pragma unroll
            for (int j = 0; j < 2; ++j) { kreg[j] = *(const u32x4*)(kg + (size_t)(k0 + 64 + 32 * j) * EV_MAIN); vreg[j] = *(const u32x4*)(vg + (size_t)(k0 + 64 + 32 * j) * EV_MAIN); }
        }
        if (k0 <= q0 + 16 * w + 15) {
        f32x4 st[2][4];
#pragma unroll
        for (int m = 0; m < 2; ++m)
#pragma unroll
            for (int kb = 0; kb < 4; ++kb) { f32x4 a = {0.f, 0.f, 0.f, 0.f};
#pragma unroll
                for (int s = 0; s < 2; ++s) a = MFMA16(ld16(Ks + (kb * 16 + r) * DA_KSTR + (m * 64 + 32 * s + 8 * g) * 2), qf[m][s], a);
                st[m][kb] = a; }
        const bool diag = (k0 + 63 > q0 + 16 * w);
        const float tsh = slope2 * (float)k0;
#pragma unroll
        for (int m = 0; m < 2; ++m) {
            float tmax = -INFINITY;
            if (diag) {
#pragma unroll
                for (int kb = 0; kb < 4; ++kb)
#pragma unroll
                    for (int e = 0; e < 4; ++e) { float v = fmaf(st[m][kb][e], sc2, cb[kb][e]);
                        v = (k0 + kb * 16 + g * 4 + e > qpos) ? -INFINITY : v;
                        st[m][kb][e] = v; tmax = fmaxf(tmax, v); }
            } else {
#pragma unroll
                for (int kb = 0; kb < 4; ++kb)
#pragma unroll
                    for (int e = 0; e < 4; ++e) { const float v = fmaf(st[m][kb][e], sc2, cb[kb][e]); st[m][kb][e] = v; tmax = fmaxf(tmax, v); }
            }
            tmax = fmaxf(tmax, __shfl_xor(tmax, 16)); tmax = fmaxf(tmax, __shfl_xor(tmax, 32));
            const float cand = tmax + tsh;
            if (__any(cand > mrun[m] + 8.0f)) {
                const float mnew = fmaxf(mrun[m], cand), alpha = ex2(mrun[m] - mnew);
                mrun[m] = mnew; lrun[m] *= alpha;
#pragma unroll
                for (int d = 0; d < 8; ++d) O[m][d] *= alpha;
            }
            const float off = mrun[m] - tsh;
            float ps = 0.f;
#pragma unroll
            for (int kb = 0; kb < 4; ++kb)
#pragma unroll
                for (int e = 0; e < 4; ++e) { const float p = ex2(st[m][kb][e] - off); st[m][kb][e] = p; ps += p; }
            lrun[m] += ps;
        }
#pragma unroll
        for (int sp = 0; sp < 2; ++sp) {
            const bf16x8 pf0 = pack8(st[0][2 * sp], st[0][2 * sp + 1]), pf1 = pack8(st[1][2 * sp], st[1][2 * sp + 1]);
#pragma unroll
            for (int d = 0; d < 8; ++d) {
                const v4i16_t lo = ldtr(Vs + (32 * sp + 4 * g + q4) * DA_VSTR + (d * 16 + 4 * p4) * 2);
                const v4i16_t hi = ldtr(Vs + (32 * sp + 16 + 4 * g + q4) * DA_VSTR + (d * 16 + 4 * p4) * 2);
                const bf16x8 vf = cat8(lo, hi);
                O[0][d] = MFMA16(vf, pf0, O[0][d]); O[1][d] = MFMA16(vf, pf1, O[1][d]);
            }
        }
        }
    }
    const float lam = *lamp, one_m_li = (li == 0) ? 0.8f : 0.52928698f;
    float inv[2];
#pragma unroll
    for (int m = 0; m < 2; ++m) { float l = lrun[m]; l += __shfl_xor(l, 16); l += __shfl_xor(l, 32); inv[m] = 1.f / l; }
    float ssq = 0.f;
    const float i0 = inv[0], i1 = lam * inv[1];
#pragma unroll
    for (int d = 0; d < 8; ++d)
#pragma unroll
        for (int e = 0; e < 4; ++e) { const float o = O[0][d][e] * i0 - O[1][d][e] * i1; O[0][d][e] = o; ssq += o * o; }
    ssq += __shfl_xor(ssq, 16); ssq += __shfl_xor(ssq, 32);
    const float rn = one_m_li * rsqf(ssq * (1.f / 128.f) + 1e-6f);
    const size_t tok = rowbase + qpos;
#pragma unroll
    for (int d = 0; d < 8; ++d) {
        const int dv0 = d * 16 + g * 4;
        const u32x2 z = *(const u32x2*)(PROJ + tok * EV_MAIN + 3072 + h * 128 + dv0);
        const f32x4 sw = *(const f32x4*)(subln_w + dv0);
        const float y0 = O[0][d][0] * rn * sw[0] * siluf(bflo(z.x)), y1 = O[0][d][1] * rn * sw[1] * siluf(bfhi(z.x));
        const float y2 = O[0][d][2] * rn * sw[2] * siluf(bflo(z.y)), y3 = O[0][d][3] * rn * sw[3] * siluf(bfhi(z.y));
        u32x2 o; o.x = pkbf(y0, y1); o.y = pkbf(y2, y3);
        *(u32x2*)(Y + tok * DM + h * 128 + dv0) = o;
    }
}

constexpr int SW_KSTR = 144, SW_VSTR = 160, SW_VOFF = 256 * SW_KSTR;
__device__ __forceinline__ void swa_item(const bf16_t* PROJ, bf16_t* Y, const float* sinks, int item, LAS unsigned char* L) {
    const int b = item >> 6, qblk = (item >> 2) & 15, kvh = item & 3;
    const int tid = fresh_tid(), lane = tid & 63, w = __builtin_amdgcn_readfirstlane(tid >> 6), r = lane & 15, g = lane >> 4, q4 = r >> 2, p4 = lane & 3;
    const int q0 = qblk * 128;
    const size_t rowbase = (size_t)b * SEQ;
    LAS unsigned char* Kb = L; LAS unsigned char* Vb = L + SW_VOFF;
    const int hq = kvh * 8 + w;
    bf16x8 qc[2]; u32x2 zc[4];
    {
        const size_t tok = rowbase + q0 + r;
#pragma unroll
        for (int s = 0; s < 2; ++s) qc[s] = *(const bf16x8*)(PROJ + tok * ODD_IN + hq * 64 + 32 * s + 8 * g);
#pragma unroll
        for (int d = 0; d < 4; ++d) zc[d] = *(const u32x2*)(PROJ + tok * ODD_IN + 2560 + hq * 64 + d * 16 + g * 4);
    }
    __syncthreads();
    {
        u32x4 kv[4], vv[4];
#pragma unroll
        for (int k = 0; k < 4; ++k) {
            const int idx = tid + NTHREADS * k, key = idx >> 3, c = idx & 7, kpos = q0 - 128 + key;
            kv[k] = (u32x4){0u, 0u, 0u, 0u}; vv[k] = (u32x4){0u, 0u, 0u, 0u};
            if (kpos >= 0) { const bf16_t* src = PROJ + (rowbase + kpos) * ODD_IN + 2048 + kvh * 64 + c * 8; kv[k] = *(const u32x4*)src; vv[k] = *(const u32x4*)(src + 256); }
        }
#pragma unroll
        for (int k = 0; k < 4; ++k) {
            const int idx = tid + NTHREADS * k, key = idx >> 3, c = idx & 7;
            *(LAS u32x4*)(Kb + key * SW_KSTR + c * 16) = kv[k]; *(LAS u32x4*)(Vb + key * SW_VSTR + c * 16) = vv[k];
        }
    }
    __syncthreads();
    const float slope2 = exp2f(-(float)(hq + 1) * 0.25f) * LOG2E, sink2 = sinks[hq] * LOG2E, sc2 = 0.125f * LOG2E;
#pragma unroll 1
    for (int rb = 0; rb < 8; ++rb) {
        const int qpos = q0 + 16 * rb + r;
        const size_t tok = rowbase + qpos;
        bf16x8 qf[2], qn[2]; u32x2 zn[4];
#pragma unroll
        for (int s = 0; s < 2; ++s) { qf[s] = qc[s]; qn[s] = qc[s]; }
#pragma unroll
        for (int d = 0; d < 4; ++d) zn[d] = zc[d];
        if (rb + 1 < 8) {
            const size_t tokn = tok + 16;
#pragma unroll
            for (int s = 0; s < 2; ++s) qn[s] = *(const bf16x8*)(PROJ + tokn * ODD_IN + hq * 64 + 32 * s + 8 * g);
#pragma unroll
            for (int d = 0; d < 4; ++d) zn[d] = *(const u32x2*)(PROJ + tokn * ODD_IN + 2560 + hq * 64 + d * 16 + g * 4);
        }
        const int sb = rb < 6 ? rb : 6;
        f32x4 st[10];
        {
            bf16x8 kf[10][2];
#pragma unroll
            for (int kb = 0; kb < 10; ++kb)
#pragma unroll
                for (int s = 0; s < 2; ++s) kf[kb][s] = ld16(Kb + ((sb + kb) * 16 + r) * SW_KSTR + (32 * s + 8 * g) * 2);
            SCHED_FENCE();
#pragma unroll
            for (int kb = 0; kb < 10; ++kb) { f32x4 a = {0.f, 0.f, 0.f, 0.f};
#pragma unroll
                for (int s = 0; s < 2; ++s) a = MFMA16(kf[kb][s], qf[s], a);
                st[kb] = a; }
        }
        float tmax = -INFINITY;
#pragma unroll
        for (int kb = 0; kb < 10; ++kb)
#pragma unroll
            for (int e = 0; e < 4; ++e) { const int kpos = q0 - 128 + (sb + kb) * 16 + g * 4 + e, dist = qpos - kpos;
                float v = st[kb][e] * sc2 - slope2 * (float)dist; v = (dist >= 0 && dist < 128 && kpos >= 0) ? v : -INFINITY; st[kb][e] = v; tmax = fmaxf(tmax, v); }
        tmax = fmaxf(tmax, __shfl_xor(tmax, 16)); tmax = fmaxf(tmax, __shfl_xor(tmax, 32));
        const float mx = fmaxf(tmax, sink2);
        float ps = 0.f;
#pragma unroll
        for (int kb = 0; kb < 10; ++kb)
#pragma unroll
            for (int e = 0; e < 4; ++e) { const float p = ex2(st[kb][e] - mx); st[kb][e] = p; ps += p; }
        ps += __shfl_xor(ps, 16); ps += __shfl_xor(ps, 32);
        const float inv = 1.f / (ps + ex2(sink2 - mx));
        f32x4 O[4];
#pragma unroll
        for (int d = 0; d < 4; ++d) O[d] = (f32x4){0.f, 0.f, 0.f, 0.f};
        {
            bf16x8 vf[5][4];
#pragma unroll
            for (int sp = 0; sp < 5; ++sp)
#pragma unroll
                for (int d = 0; d < 4; ++d) {
                    const v4i16_t lo = ldtr(Vb + ((sb + 2 * sp) * 16 + 4 * g + q4) * SW_VSTR + (d * 16 + 4 * p4) * 2);
                    const v4i16_t hi = ldtr(Vb + ((sb + 2 * sp + 1) * 16 + 4 * g + q4) * SW_VSTR + (d * 16 + 4 * p4) * 2);
                    vf[sp][d] = cat8(lo, hi);
                }
            SCHED_FENCE();
#pragma unroll
            for (int sp = 0; sp < 5; ++sp) {
                const bf16x8 pf = pack8(st[2 * sp], st[2 * sp + 1]);
#pragma unroll
                for (int d = 0; d < 4; ++d) O[d] = MFMA16(vf[sp][d], pf, O[d]);
            }
        }
#pragma unroll
        for (int d = 0; d < 4; ++d) {
            const int dv0 = d * 16 + g * 4;
            const u32x2 z = zc[d];
            const float y0 = O[d][0] * inv * siluf(bflo(z.x)), y1 = O[d][1] * inv * siluf(bfhi(z.x));
            const float y2 = O[d][2] * inv * siluf(bflo(z.y)), y3 = O[d][3] * inv * siluf(bfhi(z.y));
            u32x2 o; o.x = pkbf(y0, y1); o.y = pkbf(y2, y3);
            *(u32x2*)(Y + tok * DM + hq * 64 + dv0) = o;
        }
#pragma unroll
        for (int s = 0; s < 2; ++s) qc[s] = qn[s];
#pragma unroll
        for (int d = 0; d < 4; ++d) zc[d] = zn[d];
    }
}

constexpr int GP_RAW = 0, GP_M = 0, GP_TW = 17408, GP_TU = 26624, GP_QT = 51456, GP_KT = 69888, GP_VT = 88320, GP_SM = 106752, GP_TAPS = 108800, GP_TF = 114944, GP_STR = 288, GP_TSTR = 144;
__device__ __forceinline__ void gdn_prep_load(const Params& P, int ci, int tid, u32x4 (&rv)[7], float (&tg)[2]) {
    const int bh = ci >> 5, n = ci & 31, b = bh >> 3, h = bh & 7, t0 = n * 64;
    const size_t rowbase = (size_t)b * SEQ;
    const bf16_t* PROJ = (const bf16_t*)(P.ws + WS_PROJ);
    const float* TAIL = (const float*)(P.ws + WS_TAIL);
#pragma unroll
    for (int k = 0; k < 7; ++k) {
        const int idx = tid + NTHREADS * k, rr = idx / 48, cc = idx % 48, part = cc >> 4, c16 = cc & 15, t = t0 - 3 + rr;
        rv[k] = (u32x4){0u, 0u, 0u, 0u};
        if (idx < 67 * 48 && t >= 0) rv[k] = *(const u32x4*)(PROJ + (rowbase + t) * EV_MAIN + 4096 + part * 1024 + h * 128 + c16 * 8);
    }
    { const size_t tok = rowbase + t0 + (tid & 63); tg[0] = TAIL[tok * 16 + h]; tg[1] = TAIL[tok * 16 + 8 + h]; }
}
__device__ __forceinline__ void gdn_prep_item(const Params& P, int li, int ci, int ci_next, int hprev, u32x4 (&rv)[7], float (&tg)[2], LAS unsigned char* L) {
    const int bh = ci >> 5, n = ci & 31, b = bh >> 3, h = bh & 7, t0 = n * 64;
    const int tid = fresh_tid(), lane = tid & 63, w = __builtin_amdgcn_readfirstlane(tid >> 6), r = lane & 15, g = lane >> 4, q4 = r >> 2, p4 = lane & 3;
    const size_t rowbase = (size_t)b * SEQ;
    const bf16_t* PROJ = (const bf16_t*)(P.ws + WS_PROJ);
    const float* TAIL = (const float*)(P.ws + WS_TAIL);
    LAS float* beta_s = (LAS float*)(L + GP_SM); LAS float* gc_s = beta_s + 64; LAS float* rq_s = beta_s + 128; LAS float* rk_s = beta_s + 192;
    LAS float* taps = (LAS float*)(L + GP_TAPS);
    if (h != hprev) {
        const float* cw = P.in[12] + (size_t)li * 4 * 3072 + h * 128;
        for (int idx = tid; idx < 3 * 4 * 128; idx += NTHREADS) { const int pk = idx >> 7, c = idx & 127; taps[idx] = cw[(pk & 3) * 3072 + (pk >> 2) * 1024 + c]; }
    }
    __syncthreads();
#pragma unroll
    for (int k = 0; k < 7; ++k) {
        const int idx = tid + NTHREADS * k, rr = idx / 48, cc = idx % 48;
        if (idx < 67 * 48) *(LAS u32x4*)(L + GP_RAW + rr * 768 + cc * 16) = rv[k];
    }
    float bt = tg[0], a = tg[1];
    if (li == 1) {
        const size_t tokd = rowbase + t0 + (tid & 63);
        const float rs = ((const float*)(P.ws + WS_RSTD))[tokd];
        const float* shw2 = (const float*)(P.ws + WS_SHW) + (size_t)(8 + b) * SHW_LD + EV_MAIN;
        bt = bt * rs + shw2[h]; a = a * rs + shw2[8 + h];
    }
    gdn_prep_load(P, ci_next < 2048 ? ci_next : ci, tid, rv, tg);
    if (w == 0) {
        const float xx = a + P.in[14][li * 8 + h];
        const float ee = __expf(xx);
        const float sp = xx > 20.f ? xx : (ee < 1e-3f ? ee * (1.f - 0.5f * ee) : __logf(1.f + ee));
        float gl = -__expf(P.in[13][li * 8 + h]) * sp;
#pragma unroll
        for (int o = 1; o < 64; o <<= 1) { const float v = __shfl_up(gl, o); if (lane >= o) gl += v; }
        beta_s[lane] = __builtin_amdgcn_rcpf(1.f + __expf(-bt)); gc_s[lane] = gl;
    }
    __syncthreads();
    {
#pragma unroll
        for (int part = 0; part < 3; ++part) {
            const int strip = w;
            f32x2 wvp[4];
#pragma unroll
            for (int kk = 0; kk < 4; ++kk) wvp[kk] = *(const LAS f32x2*)(taps + (part * 4 + kk) * 128 + 2 * lane);
            float x0[11], x1[11];
#pragma unroll
            for (int i = 0; i < 11; ++i) { const unsigned u = *(const LAS unsigned*)(L + GP_RAW + (strip * 8 + i) * 768 + part * 256 + lane * 4); x0[i] = bflo(u); x1[i] = bfhi(u); }
            LAS unsigned char* dst = L + (part == 0 ? GP_QT : (part == 1 ? GP_KT : GP_VT));
            float ss[8];
#pragma unroll
            for (int e = 0; e < 8; ++e) {
                float o0 = wvp[0][0] * x0[e] + wvp[1][0] * x0[e + 1] + wvp[2][0] * x0[e + 2] + wvp[3][0] * x0[e + 3];
                float o1 = wvp[0][1] * x1[e] + wvp[1][1] * x1[e + 1] + wvp[2][1] * x1[e + 2] + wvp[3][1] * x1[e + 3];
                o0 = siluf(o0); o1 = siluf(o1);
                *(LAS unsigned*)(dst + (strip * 8 + e) * GP_STR + lane * 4) = pkbf(o0, o1);
                ss[e] = o0 * o0 + o1 * o1;
            }
            if (part < 2) {
#pragma unroll
                for (int e = 0; e < 8; ++e) ss[e] = row16_sum(ss[e]);
#pragma unroll
                for (int e = 0; e < 8; ++e) ss[e] += __shfl_xor(ss[e], 16);
#pragma unroll
                for (int e = 0; e < 8; ++e) ss[e] += __shfl_xor(ss[e], 32);
                if (lane < 8) {
                    float v = ss[0];
#pragma unroll
                    for (int e = 1; e < 8; ++e) v = (lane == e) ? ss[e] : v;
                    const float rn = rsqf(v + 1e-6f);
                    if (part == 0) rq_s[strip * 8 + lane] = rn * 0.08838834764831845f; else rk_s[strip * 8 + lane] = rn;
                }
            }
        }
    }
    __syncthreads();
    {
        bf16_t* QKM = (bf16_t*)(P.ws + WS_GQK) + (size_t)ci * 4096;
        LAS float* Mm = (LAS float*)(L + GP_M);
#pragma unroll
        for (int j = 0; j < 4; ++j) {
            const int tsk = w * 4 + j, kind = tsk >> 4, bi = (tsk >> 2) & 3, bj = tsk & 3;
            const int jt = bj * 16 + r;
            const int jtp = (bj >> 1) * 32 + (r >> 2) * 8 + (bj & 1) * 4 + (r & 3);
            if (bj > bi) {
                if (kind == 1) {
#pragma unroll
                    for (int e = 0; e < 4; ++e) QKM[(bi * 16 + g * 4 + e) * 64 + jtp] = 0;
                }
            } else {
            const LAS unsigned char* Ab = L + (kind ? GP_QT : GP_KT) + (bi * 16 + r) * GP_STR + 16 * g;
            const LAS unsigned char* Bb = L + GP_KT + (bj * 16 + r) * GP_STR + 16 * g;
            f32x4 acc = {0.f, 0.f, 0.f, 0.f};
            bf16x8 fa[4], fb[4];
#pragma unroll
            for (int s = 0; s < 4; ++s) { fa[s] = ld16(Ab + 64 * s); fb[s] = ld16(Bb + 64 * s); }
#pragma unroll
            for (int s = 0; s < 4; ++s) acc = MFMA16(fa[s], fb[s], acc);
            const float rkj = rk_s[jt], gcj = gc_s[jt];
#pragma unroll
            for (int e = 0; e < 4; ++e) {
                const int it = bi * 16 + g * 4 + e;
                const float dec = ex2((gc_s[it] - gcj) * LOG2E);
                if (kind == 0) { Mm[it * 68 + jt] = (it > jt) ? beta_s[it] * rk_s[it] * rkj * acc[e] * dec : 0.f; }
                else { const float v = (it >= jt) ? rq_s[it] * rkj * acc[e] * dec : 0.f; QKM[it * 64 + jtp] = (bf16_t)(pkbf(v, 0.f) & 0xffffu); }
            }
            }
        }
    }
    __syncthreads();
    if (w == 0) {
        const LAS float* Mm = (const LAS float*)(L + GP_M);
        LAS float* TF = (LAS float*)(L + GP_TF);
        {
            float X[16];
#pragma unroll
            for (int i = 0; i < 16; ++i) {
                float acc = (i == r) ? 1.f : 0.f;
#pragma unroll
                for (int j4 = 0; j4 < (i + 3) / 4; ++j4) {
                    const f32x4 mv = *(const LAS f32x4*)(Mm + (16 * g + i) * 68 + 16 * g + 4 * j4);
#pragma unroll
                    for (int e = 0; e < 4; ++e) if (4 * j4 + e < i) acc -= mv[e] * X[4 * j4 + e];
                }
                X[i] = acc;
            }
#pragma unroll
            for (int i = 0; i < 16; ++i) TF[(16 * g + i) * 68 + 16 * g + r] = X[i];
        }
#pragma unroll
        for (int blk = 0; blk < 6; ++blk) {
            const int ba = (blk == 0) ? 1 : (blk == 1 || blk == 3) ? 2 : 3;
            const int bb = (blk == 0 || blk == 3 || blk == 5) ? 0 : (blk == 1 || blk == 4) ? 1 : 2;
            f32x4 Pm = {0.f, 0.f, 0.f, 0.f};
#pragma unroll
            for (int c = bb; c < ba; ++c) {
                const f32x4 am = *(const LAS f32x4*)(Mm + (16 * ba + r) * 68 + 16 * c + 4 * g);
#pragma unroll
                for (int s4 = 0; s4 < 4; ++s4) Pm = __builtin_amdgcn_mfma_f32_16x16x4f32(am[s4], TF[(16 * c + 4 * g + s4) * 68 + 16 * bb + r], Pm, 0, 0, 0);
            }
            const f32x4 ta = *(const LAS f32x4*)(TF + (16 * ba + r) * 68 + 16 * ba + 4 * g);
            f32x4 Rm = {0.f, 0.f, 0.f, 0.f};
#pragma unroll
            for (int s4 = 0; s4 < 4; ++s4) Rm = __builtin_amdgcn_mfma_f32_16x16x4f32(ta[s4], Pm[s4], Rm, 0, 0, 0);
#pragma unroll
            for (int e = 0; e < 4; ++e) TF[(16 * ba + 4 * g + e) * 68 + 16 * bb + r] = -Rm[e];
        }
    } else {
        bf16_t* QG = (bf16_t*)(P.ws + WS_GQG) + (size_t)ci * 8192;
        bf16_t* KD = (bf16_t*)(P.ws + WS_GKD) + (size_t)ci * 8192;
        const float gl = gc_s[63];
        for (int idx = tid - 64; idx < 2048; idx += NTHREADS - 64) {
            const int which = idx >> 10, rem = idx & 1023, t = rem >> 4, c = rem & 15;
            const u32x4 v = *(const LAS u32x4*)(L + (which ? GP_KT : GP_QT) + t * GP_STR + c * 16);
            const float sc = which ? rk_s[t] * ex2((gl - gc_s[t]) * LOG2E) : rq_s[t] * ex2(gc_s[t] * LOG2E);
            u32x4 o; o.x = pkbf(bflo(v.x) * sc, bfhi(v.x) * sc); o.y = pkbf(bflo(v.y) * sc, bfhi(v.y) * sc);
            o.z = pkbf(bflo(v.z) * sc, bfhi(v.z) * sc); o.w = pkbf(bflo(v.w) * sc, bfhi(v.w) * sc);
            if (which) *(u32x4*)(KD + t * 128 + c * 8) = o;
            else {
                const int pb = (c >> 2) * 32 + (c & 1) * 16 + ((c >> 1) & 1) * 4;
                u32x2 lo2; lo2.x = o.x; lo2.y = o.y; u32x2 hi2; hi2.x = o.z; hi2.y = o.w;
                *(u32x2*)(QG + t * 128 + pb) = lo2; *(u32x2*)(QG + t * 128 + pb + 8) = hi2;
            }
        }
        if (tid == 64) ((float*)(P.ws + WS_GGE))[ci] = ex2(gl * LOG2E);
    }
    __syncthreads();
    {
        const LAS float* TF = (const LAS float*)(L + GP_TF);
        for (int idx = tid; idx < 4096; idx += NTHREADS) {
            const int i = idx >> 6, j = idx & 63;
            const float t = ((j >> 4) > (i >> 4)) ? 0.f : TF[i * 68 + j];
            const float bj = beta_s[j], swj = bj * rk_s[j] * ex2(gc_s[j] * LOG2E);
            *(LAS bf16_t*)(L + GP_TW + i * GP_TSTR + j * 2) = (bf16_t)(pkbf(t * swj, 0.f) & 0xffffu);
            *(LAS bf16_t*)(L + GP_TU + i * GP_TSTR + j * 2) = (bf16_t)(pkbf(t * bj, 0.f) & 0xffffu);
        }
    }
    __syncthreads();
    {
        bf16_t* Wg = (bf16_t*)(P.ws + WS_GW) + (size_t)ci * 8192;
        u32x2* UT = (u32x2*)(P.ws + WS_GUT) + (size_t)ci * 2048;
#pragma unroll 2
        for (int j = 0; j < 8; ++j) {
            const int tsk = w * 8 + j;
            f32x4 acc = {0.f, 0.f, 0.f, 0.f};
            if (tsk < 32) {
                const int dkb = tsk >> 2, tb = tsk & 3, it = tb * 16 + r;
#pragma unroll
                for (int s = 0; s < 2; ++s) {
                    const v4i16_t lo = ldtr(L + GP_KT + (32 * s + 4 * g + q4) * GP_STR + (dkb * 16 + 4 * p4) * 2);
                    const v4i16_t hi = ldtr(L + GP_KT + (32 * s + 16 + 4 * g + q4) * GP_STR + (dkb * 16 + 4 * p4) * 2);
                    const v4i16_t blo = ld8(L + GP_TW + it * GP_TSTR + (32 * s + 4 * g) * 2), bhi = ld8(L + GP_TW + it * GP_TSTR + (32 * s + 16 + 4 * g) * 2);
                    acc = MFMA16(cat8(lo, hi), cat8(blo, bhi), acc);
                }
                u32x2 o; o.x = pkbf(acc[0], acc[1]); o.y = pkbf(acc[2], acc[3]);
                *(u32x2*)(Wg + it * 128 + (dkb >> 1) * 32 + g * 8 + (dkb & 1) * 4) = o;
            } else {
                const int tb = (tsk - 32) >> 3, dvb = (tsk - 32) & 7, it = tb * 16 + r;
#pragma unroll
                for (int s = 0; s < 2; ++s) {
                    const v4i16_t alo = ld8(L + GP_TU + it * GP_TSTR + (32 * s + 4 * g) * 2), ahi = ld8(L + GP_TU + it * GP_TSTR + (32 * s + 16 + 4 * g) * 2);
                    const v4i16_t lo = ldtr(L + GP_VT + (32 * s + 4 * g + q4) * GP_STR + (dvb * 16 + 4 * p4) * 2);
                    const v4i16_t hi = ldtr(L + GP_VT + (32 * s + 16 + 4 * g + q4) * GP_STR + (dvb * 16 + 4 * p4) * 2);
                    acc = MFMA16(cat8(alo, ahi), cat8(lo, hi), acc);
                }
                u32x2 o; o.x = pkbf(acc[0], acc[1]); o.y = pkbf(acc[2], acc[3]);
                UT[(tb * 8 + dvb) * 64 + lane] = o;
            }
        }
    }
}

constexpr int GS_W = 0, GS_QG = 18432, GS_KD = 36864, GS_QK = 55296, GS_SSQ = 64512, GS_STR = 288, GS_ASTR = 272, GS_QSTR = 144;
__device__ __forceinline__ void gdn_scan_item(const Params& P, int li, int bh, LAS unsigned char* L) {
    const int b = bh >> 3, h = bh & 7;
    const int tid = fresh_tid(), lane = tid & 63, w = __builtin_amdgcn_readfirstlane(tid >> 6), r = lane & 15, g = lane >> 4, q4 = r >> 2, p4 = lane & 3;
    const size_t rowbase = (size_t)b * SEQ;
    const bf16_t* PROJ = (const bf16_t*)(P.ws + WS_PROJ);
    bf16_t* Y = (bf16_t*)(P.ws + WS_HY);
    const u32x4* Wg = (const u32x4*)(P.ws + WS_GW); const u32x4* QGg = (const u32x4*)(P.ws + WS_GQG); const u32x4* KDg = (const u32x4*)(P.ws + WS_GKD);
    const u32x4* QKg = (const u32x4*)(P.ws + WS_GQK); const u32x2* UTg = (const u32x2*)(P.ws + WS_GUT); const float* GEg = (const float*)(P.ws + WS_GGE);
    const float dnw = P.in[15][li * 128 + 16 * w + r];
    LAS float* ssq_s = (LAS float*)(L + GS_SSQ);
    f32x4 S[8];
#pragma unroll
    for (int i = 0; i < 8; ++i) S[i] = (f32x4){0.f, 0.f, 0.f, 0.f};
    u32x4 pw[2], pq[2], pk[2], pqk; u32x2 pu[4]; float pge;
    {
        const size_t ci = (size_t)bh * 32;
#pragma unroll
        for (int j = 0; j < 2; ++j) { pw[j] = Wg[ci * 1024 + tid + 512 * j]; pq[j] = QGg[ci * 1024 + tid + 512 * j]; pk[j] = KDg[ci * 1024 + tid + 512 * j]; }
        pqk = QKg[ci * 512 + tid];
#pragma unroll
        for (int tb = 0; tb < 4; ++tb) pu[tb] = UTg[ci * 2048 + (tb * 8 + w) * 64 + lane];
        pge = GEg[ci];
    }
    for (int n = 0; n < 32; ++n) {
        __syncthreads();
#pragma unroll
        for (int j = 0; j < 2; ++j) { const int idx = tid + 512 * j, row = idx >> 4, c = idx & 15;
            *(LAS u32x4*)(L + GS_W + row * GS_ASTR + c * 16) = pw[j]; *(LAS u32x4*)(L + GS_QG + row * GS_ASTR + c * 16) = pq[j]; *(LAS u32x4*)(L + GS_KD + row * GS_STR + c * 16) = pk[j]; }
        *(LAS u32x4*)(L + GS_QK + (tid >> 3) * GS_QSTR + (tid & 7) * 16) = pqk;
        u32x2 puc[4];
#pragma unroll
        for (int tb = 0; tb < 4; ++tb) puc[tb] = pu[tb];
        const float ge = pge;
        __syncthreads();
        bf16x8 sb[4];
#pragma unroll
        for (int s = 0; s < 4; ++s) sb[s] = pack8(S[2 * s], S[2 * s + 1]);
        f32x4 ws[4], oq[4];
#pragma unroll
        for (int tb = 0; tb < 4; ++tb) {
            bf16x8 wf[4], qf[4];
#pragma unroll
            for (int s = 0; s < 4; ++s) {
                wf[s] = ld16(L + GS_W + (tb * 16 + r) * GS_ASTR + (32 * s + 8 * g) * 2);
                qf[s] = ld16(L + GS_QG + (tb * 16 + r) * GS_ASTR + (32 * s + 8 * g) * 2);
            }
            SCHED_FENCE();
            f32x4 a = {0.f, 0.f, 0.f, 0.f}, c = {0.f, 0.f, 0.f, 0.f};
#pragma unroll
            for (int s = 0; s < 4; ++s) { a = MFMA16(wf[s], sb[s], a); c = MFMA16(qf[s], sb[s], c); }
            ws[tb] = a; oq[tb] = c;
        }
        if (n + 1 < 32) {
            const size_t ci = (size_t)bh * 32 + n + 1;
#pragma unroll
            for (int j = 0; j < 2; ++j) { pw[j] = Wg[ci * 1024 + tid + 512 * j]; pq[j] = QGg[ci * 1024 + tid + 512 * j]; pk[j] = KDg[ci * 1024 + tid + 512 * j]; }
            pqk = QKg[ci * 512 + tid];
#pragma unroll
            for (int tb = 0; tb < 4; ++tb) pu[tb] = UTg[ci * 2048 + (tb * 8 + w) * 64 + lane];
            pge = GEg[ci];
        }
        bf16_t zr[4][4];
#pragma unroll
        for (int tb = 0; tb < 4; ++tb)
#pragma unroll
            for (int e = 0; e < 4; ++e) zr[tb][e] = PROJ[(rowbase + n * 64 + tb * 16 + g * 4 + e) * EV_MAIN + 7168 + h * 128 + 16 * w + r];
        bf16x8 vb[2];
#pragma unroll
        for (int sp = 0; sp < 2; ++sp) {
            const f32x4 u0 = {bflo(puc[2 * sp].x), bfhi(puc[2 * sp].x), bflo(puc[2 * sp].y), bfhi(puc[2 * sp].y)};
            const f32x4 u1 = {bflo(puc[2 * sp + 1].x), bfhi(puc[2 * sp + 1].x), bflo(puc[2 * sp + 1].y), bfhi(puc[2 * sp + 1].y)};
            vb[sp] = pack8(u0 - ws[2 * sp], u1 - ws[2 * sp + 1]);
        }
        {
            bf16x8 af[4][2];
#pragma unroll
            for (int tb = 0; tb < 4; ++tb)
#pragma unroll
                for (int sp = 0; sp < 2; ++sp) af[tb][sp] = ld16(L + GS_QK + (tb * 16 + r) * GS_QSTR + (32 * sp + 8 * g) * 2);
            SCHED_FENCE();
#pragma unroll
            for (int tb = 0; tb < 4; ++tb)
#pragma unroll
                for (int sp = 0; sp < 2; ++sp) oq[tb] = MFMA16(af[tb][sp], vb[sp], oq[tb]);
        }
#pragma unroll
        for (int rh = 0; rh < 2; ++rh) {
            bf16x8 kf[4][2];
#pragma unroll
            for (int rq = 0; rq < 4; ++rq)
#pragma unroll
                for (int sp = 0; sp < 2; ++sp) {
                    const int rb = rh * 4 + rq;
                    const v4i16_t lo = ldtr(L + GS_KD + (32 * sp + 4 * g + q4) * GS_STR + (rb * 16 + 4 * p4) * 2);
                    const v4i16_t hi = ldtr(L + GS_KD + (32 * sp + 16 + 4 * g + q4) * GS_STR + (rb * 16 + 4 * p4) * 2);
                    kf[rq][sp] = cat8(lo, hi);
                }
            SCHED_FENCE();
#pragma unroll
            for (int rq = 0; rq < 4; ++rq) {
                const int rb = rh * 4 + rq;
                f32x4 acc = S[rb] * ge;
#pragma unroll
                for (int sp = 0; sp < 2; ++sp) acc = MFMA16(kf[rq][sp], vb[sp], acc);
                S[rb] = acc;
            }
        }
#pragma unroll
        for (int tb = 0; tb < 4; ++tb)
#pragma unroll
            for (int e = 0; e < 4; ++e) {
                const float ss = row16_sum(oq[tb][e] * oq[tb][e]);
                if (r == 0) ssq_s[(tb * 16 + g * 4 + e) * 8 + w] = ss;
            }
        __syncthreads();
#pragma unroll
        for (int tb = 0; tb < 4; ++tb)
#pragma unroll
            for (int e = 0; e < 4; ++e) {
                const int tl = tb * 16 + g * 4 + e;
                const f32x4 t0 = *(const LAS f32x4*)(ssq_s + tl * 8), t1 = *(const LAS f32x4*)(ssq_s + tl * 8 + 4);
                const float tot = ((t0[0] + t0[1]) + (t0[2] + t0[3])) + ((t1[0] + t1[1]) + (t1[2] + t1[3]));
                const float rn = rsqf(tot * (1.f / 128.f) + 1e-6f);
                const float y = oq[tb][e] * rn * dnw * siluf(bf2f(zr[tb][e]));
                Y[(rowbase + n * 64 + tl) * DM + 1024 + h * 128 + 16 * w + r] = (bf16_t)(pkbf(y, 0.f) & 0xffffu);
            }
    }
}

#ifndef PROBE_SYNCS
#define PROBE_SYNCS 0
#endif
#ifndef PROBE_DUP
#define PROBE_DUP 0
#endif
#define PHASE_VARS const int tid = fresh_tid(), lane = tid & 63, wave = __builtin_amdgcn_readfirstlane(tid >> 6); \
    const int wg = fresh_s((int)blockIdx.x), nwg = fresh_s((int)gridDim.x), gw = wg * NWAVES + wave, ngw = nwg * NWAVES; \
    const Params P = load_params(); \
    unsigned char* ws = P.ws; (void)tid; (void)lane; (void)gw; (void)ngw; (void)ws;
__device__ __forceinline__ Params load_params() {
#if defined(__HIP_DEVICE_COMPILE__)
    typedef const __attribute__((address_space(4))) unsigned long long* KPtr;
    KPtr kp = (KPtr)__builtin_amdgcn_kernarg_segment_ptr(); asm volatile("" : "+s"(kp));
    Params p;
#pragma unroll
    for (int i = 0; i < 20; ++i) p.in[i] = (const float*)(const __attribute__((address_space(1))) float*)kp[i];
    p.out = (float*)(__attribute__((address_space(1))) float*)kp[20]; p.ws = (unsigned char*)(__attribute__((address_space(1))) unsigned char*)kp[21];
    return p;
#else
    return Params{};
#endif
}
__global__ void __launch_bounds__(NTHREADS, 2) mega_fwd(Params Parg) {
    extern __shared__ __attribute__((aligned(16))) unsigned char lds_raw[];
    LAS unsigned char* L = (LAS unsigned char*)lds_raw;
    cg::grid_group grid = cg::this_grid();
    if (fresh_s((int)gridDim.x) == 0x7ffffff) grid.sync();
    if (threadIdx.x < 8) ((LAS unsigned*)(L + XBST_OFF))[threadIdx.x] = 0u;
    __syncthreads();
    (void)xcd_barrier_post((unsigned*)(Parg.ws + WS_BAR), (volatile LAS unsigned*)(L + XBST_OFF));
#define GSYNC() do { XcdBarrier xb_; xb_.bar = (unsigned*)(load_params().ws + WS_BAR); xb_.x = xb_xcc_id(); xb_.st = (volatile LAS unsigned*)(L + XBST_OFF); xcd_barrier(xb_); } while (0)

    for (int rep = 0; rep < ((PROBE_DUP & 1) ? 2 : 1); ++rep)
    { PHASE_VARS
      __syncthreads();
      phase_mod(P, L, wg, nwg);
      __syncthreads();
      phase_convert(P, L, gw, ngw, wave, lane); }
    GSYNC();

#pragma unroll 1
    for (int layer = 0; layer < 4; ++layer) {
        { PHASE_VARS
          if (layer == 0) {
              phase_norm(P.in[0], P.in[2], (const float*)(ws + WS_MOD), (bf16_t*)(ws + WS_HY), gw, ngw, lane);
              { f32x4* tz = (f32x4*)(ws + WS_TAIL); for (int i = gw * 64 + lane; i < MROWS * 16 / 4; i += ngw * 64) tz[i] = (f32x4){0.f, 0.f, 0.f, 0.f}; }
              phase_tables(P, gw, ngw, lane);
          } else phase_rstd(P, (layer & 1) == 0, gw, ngw, lane); }
        GSYNC();
        for (int rep = 0; rep < ((PROBE_DUP & 4) ? 2 : 1); ++rep)
        { PHASE_VARS
          const int li = layer >> 1; const bool even = (layer & 1) == 0;
          const int N = even ? EV_MAIN : ODD_IN;
          const bf16_t* Bt = even ? (const bf16_t*)(ws + WS_WT_EVIN) + (size_t)li * EV_MAIN * DM : (const bf16_t*)(ws + WS_WT_ODIN) + (size_t)li * ODD_IN * DM;
          const bf16_t* Aop = (layer == 0) ? (const bf16_t*)(ws + WS_HY) : (const bf16_t*)(ws + WS_XS);
          if (even) phase_tail(Aop, (const bf16_t*)(ws + WS_WT_EVTAIL) + (size_t)li * 16 * DM, (float*)(ws + WS_TAIL), gw, ngw, lane);
          pg8::Gemm gm{Aop, Bt, MROWS, N, DM}; pg8::StaticOrder S; S.init(MROWS, N, nwg, wg);
          if (layer == 0) { pg8::EpiProj E{(bf16_t*)(ws + WS_PROJ), N}; pg8::gemm_phase<pg8::EpiProj, pg8::StaticOrder, true, true>(L, gm, S, E); }
          else { pg8::EpiProjN E{(bf16_t*)(ws + WS_PROJ), N, (const float*)(ws + WS_RSTD), (const float*)(ws + WS_SHW) + (size_t)(layer - 1) * 8 * SHW_LD};
                 pg8::gemm_phase<pg8::EpiProjN, pg8::StaticOrder, true, true>(L, gm, S, E); } }
        GSYNC();
        if ((layer & 1) == 0) {
            for (int rep = 0; rep < ((PROBE_DUP & 8) ? 2 : 1); ++rep)
            { PHASE_VARS
              const int li = layer >> 1;
              u32x4 rv[7]; float tg[2];
              gdn_prep_load(P, wg, tid, rv, tg);
              int hprev = -1;
              for (int ci = wg; ci < 2048; ci += nwg) { gdn_prep_item(P, li, ci, ci + nwg, hprev, rv, tg, L); hprev = (ci >> 5) & 7; } }
            GSYNC();
            for (int rep = 0; rep < ((PROBE_DUP & (16 | 128 | 256)) ? 2 : 1); ++rep)
            { PHASE_VARS
              const int li = (layer >> 1) + 2 * rep;
              unsigned* ctr = (unsigned*)(ws + WS_CTL) + 64 + (li & 3) * 64; LAS int* qslot = (LAS int*)(L + QSLOT_OFF);
              int qcur = (int)(xb_xcc_id() & 7u), qtried = 0;
              for (;;) {
                  __syncthreads();
                  if (tid == 0) {
                      int it = -1;
                      while (qtried < 8) {
                          const int t = (int)atomicAdd(&ctr[qcur * 8], 1u);
                          if (t < 136) { it = (t < 8) ? (qcur + 8 * t) : 64 + ((t - 8) >> 3) * 64 + qcur + 8 * ((t - 8) & 7); break; }
                          qcur = (qcur + 1) & 7; ++qtried;
                      }
                      *qslot = it;
                  }
                  __syncthreads();
                  const int item = *qslot;
                  if (item < 0) break;
                  if (item < 64) gdn_scan_item(P, li & 1, item, L);
                  else diff_attn_item((const bf16_t*)(ws + WS_PROJ), (bf16_t*)(ws + WS_HY), P.in[11] + (li & 1) * 128, (const float*)(ws + WS_CTL) + 512 + (li & 1), li & 1, item - 64, L);
              } }
        } else {
            for (int rep = 0; rep < ((PROBE_DUP & 32) ? 2 : 1); ++rep)
            { PHASE_VARS
              const int li = layer >> 1;
              for (int item = wg; item < 512; item += nwg) swa_item((const bf16_t*)(ws + WS_PROJ), (bf16_t*)(ws + WS_HY), P.in[18] + li * 32, item, L); }
        }
        GSYNC();
        for (int rep = 0; rep < (((PROBE_DUP & 64) && layer == 0) ? 2 : 1); ++rep)
        { PHASE_VARS
          const int li = layer >> 1; const bool even = (layer & 1) == 0;
          const bf16_t* Bt = even ? (const bf16_t*)(ws + WS_WT_EVOUT) + (size_t)li * DM * DM : (const bf16_t*)(ws + WS_WT_ODOUT) + (size_t)li * DM * DM;
          pg8::Gemm gm{(const bf16_t*)(ws + WS_HY), Bt, MROWS, DM, DM}; pg8::StaticOrder S; S.init(MROWS, DM, nwg, wg);
          if (layer == 3) { pg8::EpiResid E{P.out, P.out, (const float*)(ws + WS_MOD) + (size_t)layer * 8 * 6144 + 2 * DM};
              pg8::gemm_phase<pg8::EpiResid, pg8::StaticOrder, true, true>(L, gm, S, E); }
          else { pg8::EpiResid2 E{layer == 0 ? P.in[0] : P.out, P.out, (const float*)(ws + WS_MOD) + (size_t)layer * 8 * 6144 + 2 * DM,
                                  (const float*)(ws + WS_CS) + (size_t)layer * 8 * DM, (bf16_t*)(ws + WS_XS), (float*)(ws + WS_SSQP)};
              pg8::gemm_phase<pg8::EpiResid2, pg8::StaticOrder, true, true>(L, gm, S, E); } }
        GSYNC();
    }
    for (int i = 0; i < PROBE_SYNCS; ++i) GSYNC();
    { PHASE_VARS
      phase_final(P.out, P.in[19], gw, ngw, lane); }
}

extern "C" void kernel_launch(void* const* d_in, const int* in_sizes, int n_in, void* d_out, int out_size, void* d_ws, size_t ws_size, hipStream_t stream) {
    static int grid = 0;
    if (grid == 0) {
        if (n_in != 20 || out_size != MROWS * DM || ws_size < WS_END) { fprintf(stderr, "kernel_launch: unexpected shapes (n_in %d out %d ws %zu need %zu)\n", n_in, out_size, ws_size, (size_t)WS_END); grid = -1; return; }
        int dev = 0, cus = 0, per_cu = 0;
        (void)hipGetDevice(&dev);
        (void)hipDeviceGetAttribute(&cus, hipDeviceAttributeMultiprocessorCount, dev);
        if (hipFuncSetAttribute((const void*)mega_fwd, hipFuncAttributeMaxDynamicSharedMemorySize, LDS_BYTES) != hipSuccess) { fprintf(stderr, "kernel_launch: hipFuncSetAttribute failed\n"); grid = -1; return; }
        if (hipOccupancyMaxActiveBlocksPerMultiprocessor(&per_cu, (const void*)mega_fwd, NTHREADS, LDS_BYTES) != hipSuccess || per_cu < 1) { fprintf(stderr, "kernel_launch: occupancy query gave %d\n", per_cu); }
        (void)hipGetLastError();
        grid = cus > 0 ? cus : 256;
    }
    if (grid < 0) return;
    (void)hipMemsetAsync((char*)d_ws + WS_CTL, 0, CTL_BYTES, stream);
    Params p{};
    for (int i = 0; i < 20; ++i) p.in[i] = (const float*)d_in[i];
    p.out = (float*)d_out; p.ws = (unsigned char*)d_ws;
    void* args[] = {&p};
    hipError_t e = hipLaunchCooperativeKernel((const void*)mega_fwd, dim3(grid), dim3(NTHREADS), args, LDS_BYTES, stream);
    if (e != hipSuccess) fprintf(stderr, "kernel_launch: cooperative launch failed: %s (grid %d)\n", hipGetErrorString(e), grid);
}
```
